# Optimizing an MI355X kernel written in HIP

```python
import jax, jax.numpy as jnp
from jax import lax
import numpy as np

D_MODEL = 1024
BATCH = 8
SEQ = 4096
DEPTH = 1

LRU_WIDTH = 512
LRU_BLOCKS = 8
LRU_BLOCK_DIM = LRU_WIDTH // LRU_BLOCKS
LRU_CONV = 4
LRU_C = 8.0
N_HEADS = 8
HEAD_DIM = 64
ATT_WIDTH = N_HEADS * HEAD_DIM
MIX_WIDTH = LRU_WIDTH + ATT_WIDTH
IN_WIDTH = 2 * LRU_WIDTH + 3 * ATT_WIDTH
MOBA_BLOCK = 256
MOBA_TOPK = 3
Q_CHUNK = 32
D_FF = 3072
FFN_CONV = 3
PLE_DIM = 256
EPS = 1e-6
NEG = -1e30

kernel_name = "hymba_rglru_moba_convffn_ple"


def rmsnorm(x, g):
    xf = x.astype(jnp.float32)
    y = xf * lax.rsqrt(jnp.mean(xf * xf, axis=-1, keepdims=True) + EPS)
    return (y * g.astype(jnp.float32)).astype(x.dtype)


def causal_dwconv(x, w, b):
    K, C = w.shape
    y = lax.conv_general_dilated(
        x, w.reshape(K, 1, C).astype(x.dtype), window_strides=(1,), padding=[(K - 1, 0)],
        dimension_numbers=("NWC", "WIO", "NWC"), feature_group_count=C)
    return y + b.astype(x.dtype)


def rglru(xc, wa, ba, wx, bx, lam):
    B, T, W = xc.shape
    xb = xc.reshape(B, T, LRU_BLOCKS, LRU_BLOCK_DIM)
    r = jax.nn.sigmoid(jnp.einsum("btnc,ncd->btnd", xb, wa).reshape(B, T, W) + ba)
    i = jax.nn.sigmoid(jnp.einsum("btnc,ncd->btnd", xb, wx).reshape(B, T, W) + bx)
    log_a = -LRU_C * r.astype(jnp.float32) * jax.nn.softplus(-lam.astype(jnp.float32))
    a = jnp.exp(log_a)
    mult = jnp.sqrt(-jnp.expm1(2.0 * log_a))
    mult = mult.at[:, 0].set(1.0)
    b = mult * (i * xc).astype(jnp.float32)

    def combine(left, right):
        a1, b1 = left
        a2, b2 = right
        return a1 * a2, a2 * b1 + b2

    _, hs = lax.associative_scan(combine, (a, b), axis=1)
    return hs.astype(xc.dtype)


def moba_attention(q, k, v, slopes):
    B, T, H, Dh = q.shape
    L = MOBA_BLOCK
    NB = -(-T // L)
    Tp = NB * L
    if Tp != T:
        pad = ((0, 0), (0, Tp - T), (0, 0), (0, 0))
        q, k, v = jnp.pad(q, pad), jnp.pad(k, pad), jnp.pad(v, pad)
    scale = 1.0 / np.sqrt(Dh)
    qh = q.transpose(0, 2, 1, 3)
    kb = k.transpose(0, 2, 1, 3).reshape(B, H, NB, L, Dh)
    vb = v.transpose(0, 2, 1, 3).reshape(B, H, NB, L, Dh)

    k_mean = jnp.mean(kb.astype(jnp.float32), axis=3)
    gate = jnp.einsum("bhtd,bhnd->bhtn", qh.astype(jnp.float32), k_mean)
    q_blk = jnp.arange(Tp) // L
    past = jnp.arange(NB)[None, :] < q_blk[:, None]
    gate = jnp.where(past[None, None], gate, NEG)
    n_sel = min(MOBA_TOPK, NB)
    _, sel = lax.top_k(gate, n_sel)
    valid = jnp.arange(n_sel)[None, :] < jnp.minimum(q_blk, n_sel)[:, None]

    n_chunks = Tp // Q_CHUNK
    q_c = qh.reshape(B, H, n_chunks, Q_CHUNK, Dh).transpose(2, 0, 1, 3, 4)
    sel_c = sel.reshape(B, H, n_chunks, Q_CHUNK, n_sel).transpose(2, 0, 1, 3, 4)
    valid_c = valid.reshape(n_chunks, Q_CHUNK, n_sel)
    idx_c = jnp.arange(n_chunks, dtype=jnp.int32)
    bi = jnp.arange(B)[:, None, None, None]
    hi = jnp.arange(H)[None, :, None, None]
    slope_f = slopes.astype(jnp.float32)

    def body(args):
        qc, selc, validc, c = args
        t_pos = c * Q_CHUNK + jnp.arange(Q_CHUNK)
        qb = (c * Q_CHUNK) // L
        ks = kb[bi, hi, selc]
        vs = vb[bi, hi, selc]
        s_pos = selc[..., None] * L + jnp.arange(L)
        dist_sel = (t_pos[None, None, :, None, None] - s_pos).astype(jnp.float32)
        lg_sel = jnp.einsum("bhcd,bhcsld->bhcsl", qc, ks, preferred_element_type=jnp.float32) * scale
        lg_sel = lg_sel - slope_f[None, :, None, None, None] * dist_sel
        lg_sel = jnp.where(validc[None, None, :, :, None], lg_sel, NEG)
        k_own = lax.dynamic_index_in_dim(kb, qb, axis=2, keepdims=False)
        v_own = lax.dynamic_index_in_dim(vb, qb, axis=2, keepdims=False)
        s_own = qb * L + jnp.arange(L)
        dist_own = (t_pos[:, None] - s_own[None, :]).astype(jnp.float32)
        lg_own = jnp.einsum("bhcd,bhld->bhcl", qc, k_own, preferred_element_type=jnp.float32) * scale
        lg_own = lg_own - slope_f[None, :, None, None] * dist_own[None, None]
        lg_own = jnp.where((dist_own >= 0)[None, None], lg_own, NEG)
        logits = jnp.concatenate([lg_sel.reshape(B, H, Q_CHUNK, n_sel * L), lg_own], axis=-1)
        w = jax.nn.softmax(logits, axis=-1).astype(vb.dtype)
        w_sel = w[..., : n_sel * L].reshape(B, H, Q_CHUNK, n_sel, L)
        w_own = w[..., n_sel * L:]
        out = (jnp.einsum("bhcsl,bhcsld->bhcd", w_sel, vs, preferred_element_type=jnp.float32)
               + jnp.einsum("bhcl,bhld->bhcd", w_own, v_own, preferred_element_type=jnp.float32))
        return out.astype(vb.dtype)

    out = lax.map(body, (q_c, sel_c, valid_c, idx_c))
    out = out.transpose(1, 0, 3, 2, 4).reshape(B, Tp, H * Dh)
    return out[:, :T]


def setup_inputs(seed: int = 0) -> dict:
    key = jax.random.key(seed)
    ks = jax.random.split(key, 24)
    f32 = jnp.float32

    def nrm(k, shape, scale):
        return jax.random.normal(k, shape, f32) * scale

    def gain(k, shape):
        return 1.0 + 0.05 * jax.random.normal(k, shape, f32)

    u = jax.random.uniform(ks[9], (DEPTH, LRU_WIDTH), f32, 0.9, 0.999)
    a0 = u ** (1.0 / LRU_C)
    lru_lambda = jnp.log(a0) - jnp.log1p(-a0)
    return {
        "x": nrm(ks[0], (BATCH, SEQ, D_MODEL), 1.0),
        "p": nrm(ks[1], (DEPTH, BATCH, SEQ, PLE_DIM), 1.0),
        "ln_mix": gain(ks[2], (DEPTH, D_MODEL)),
        "w_in": nrm(ks[3], (DEPTH, D_MODEL, IN_WIDTH), D_MODEL ** -0.5),
        "conv_w": nrm(ks[4], (DEPTH, LRU_CONV, LRU_WIDTH), LRU_CONV ** -0.5),
        "conv_b": nrm(ks[5], (DEPTH, LRU_WIDTH), 0.01),
        "gate_a_w": nrm(ks[6], (DEPTH, LRU_BLOCKS, LRU_BLOCK_DIM, LRU_BLOCK_DIM), LRU_BLOCK_DIM ** -0.5),
        "gate_a_b": nrm(ks[7], (DEPTH, LRU_WIDTH), 0.01),
        "gate_x_w": nrm(ks[8], (DEPTH, LRU_BLOCKS, LRU_BLOCK_DIM, LRU_BLOCK_DIM), LRU_BLOCK_DIM ** -0.5),
        "gate_x_b": nrm(ks[10], (DEPTH, LRU_WIDTH), 0.01),
        "lru_lambda": lru_lambda,
        "q_gain": gain(ks[11], (DEPTH, HEAD_DIM)),
        "k_gain": gain(ks[12], (DEPTH, HEAD_DIM)),
        "w_out": nrm(ks[13], (DEPTH, MIX_WIDTH, D_MODEL), MIX_WIDTH ** -0.5),
        "ln_ffn": gain(ks[14], (DEPTH, D_MODEL)),
        "w_up": nrm(ks[15], (DEPTH, D_MODEL, 2 * D_FF), D_MODEL ** -0.5),
        "ffn_conv_w": nrm(ks[16], (DEPTH, FFN_CONV, D_FF), FFN_CONV ** -0.5),
        "ffn_conv_b": nrm(ks[17], (DEPTH, D_FF), 0.01),
        "w_down": nrm(ks[18], (DEPTH, D_FF, D_MODEL), D_FF ** -0.5),
        "ln_ple": gain(ks[19], (DEPTH, D_MODEL)),
        "w_ple_gate": nrm(ks[20], (DEPTH, D_MODEL, D_MODEL), D_MODEL ** -0.5),
        "w_ple_proj": nrm(ks[21], (DEPTH, PLE_DIM, D_MODEL), PLE_DIM ** -0.5),
    }


def reference(x, p, ln_mix, w_in, conv_w, conv_b, gate_a_w, gate_a_b, gate_x_w, gate_x_b,
              lru_lambda, q_gain, k_gain, w_out, ln_ffn, w_up, ffn_conv_w, ffn_conv_b, w_down,
              ln_ple, w_ple_gate, w_ple_proj):
    B, T, _ = x.shape
    slopes = 2.0 ** (-8.0 * jnp.arange(1, N_HEADS + 1, dtype=jnp.float32) / N_HEADS)
    split_at = [LRU_WIDTH, 2 * LRU_WIDTH, 2 * LRU_WIDTH + ATT_WIDTH, 2 * LRU_WIDTH + 2 * ATT_WIDTH]
    h = x
    for i in range(DEPTH):
        u = rmsnorm(h, ln_mix[i])
        proj = u @ w_in[i]
        x_lru, g_lru, q, k, v = jnp.split(proj, split_at, axis=-1)
        xc = causal_dwconv(x_lru, conv_w[i], conv_b[i])
        y_lru = rglru(xc, gate_a_w[i], gate_a_b[i], gate_x_w[i], gate_x_b[i], lru_lambda[i])
        y_lru = y_lru * jax.nn.gelu(g_lru)
        q = rmsnorm(q.reshape(B, T, N_HEADS, HEAD_DIM), q_gain[i])
        k = rmsnorm(k.reshape(B, T, N_HEADS, HEAD_DIM), k_gain[i])
        v = v.reshape(B, T, N_HEADS, HEAD_DIM)
        y_att = moba_attention(q, k, v, slopes)
        h = h + jnp.concatenate([y_lru, y_att], axis=-1) @ w_out[i]
        u = rmsnorm(h, ln_ffn[i])
        g_up, v_up = jnp.split(u @ w_up[i], 2, axis=-1)
        g_up = causal_dwconv(g_up, ffn_conv_w[i], ffn_conv_b[i])
        h = h + (jax.nn.gelu(g_up) * v_up) @ w_down[i]
        gate = jax.nn.sigmoid(rmsnorm(h, ln_ple[i]) @ w_ple_gate[i])
        h = h + gate * (p[i].astype(h.dtype) @ w_ple_proj[i])
    return h
```

```cpp
#include <hip/hip_runtime.h>
#include <cstdio>
#include <cstdint>

constexpr int BATCH = 8, SEQ = 4096, DM = 1024, MTOK = BATCH * SEQ;
constexpr int LRU_W = 512, ATT_W = 512, NH = 8, HD = 64, INW = 2560, DFF = 3072, PLE = 256;
constexpr float EPS = 1e-6f;
constexpr float LOG2E = 1.4426950408889634f;
constexpr float C2 = 0.125f * LOG2E;

typedef unsigned short bf16_t;
typedef short bf16x8 __attribute__((ext_vector_type(8)));
typedef float f32x4 __attribute__((ext_vector_type(4)));
typedef float f32x2 __attribute__((ext_vector_type(2)));
typedef unsigned u32x4 __attribute__((ext_vector_type(4)));
typedef unsigned u32x2 __attribute__((ext_vector_type(2)));

__device__ __forceinline__ unsigned f2bf(float f) { unsigned u = __builtin_bit_cast(unsigned, f); return (u + 0x7fffu + ((u >> 16) & 1u)) >> 16; }
__device__ __forceinline__ unsigned pk2(float lo, float hi) { return f2bf(lo) | (f2bf(hi) << 16); }
__device__ __forceinline__ float bf2f(unsigned v) { return __builtin_bit_cast(float, v << 16); }
__device__ __forceinline__ float gelu_tanh(float x) {
    const float u2 = x * (1.5957691216f + 0.0713548163f * x * x);
    return x / (1.0f + __expf(-u2));
}
__device__ __forceinline__ float sigmoidf_(float x) { return 1.0f / (1.0f + __expf(-x)); }

namespace pg8 {
#define PG8_LAS __attribute__((address_space(3)))
constexpr int BM = 256, BK = 64, HALF = 128, HTB = HALF * BK * 2, STAGE_BYTES = 8 * HTB, NXCD = 8, WGM = 8;

__host__ __device__ __forceinline__ int lds_byte(int r, int c) { const int st = (r >> 4) * 2 + (c >> 5), rr = r & 15, cc = c & 31, ob = rr * 64 + cc * 2; return st * 1024 + (ob ^ (((ob >> 9) & 1) << 5)); }
__host__ __device__ __forceinline__ void stage_rc(int b, int& R, int& C) { const int st = b / 1024, sb = b % 1024, swz = sb ^ (((sb >> 9) & 1) << 5); R = (st >> 1) * 16 + swz / 64; C = (st & 1) * 32 + (swz % 64) / 2; }
__host__ __device__ __forceinline__ int perm32(int rho) { const int n = rho >> 4, i = rho & 15; return 8 * (i >> 2) + 4 * n + (i & 3); }

struct Unit { int pm, pn; };
struct Gemm { const bf16_t* A; const bf16_t* Bt; size_t bhalf; int M, N, K, pad; };

struct StaticOrder {
    int nM, nN, nwg, G, c;
    __host__ __device__ void init(int M, int N, int G_, int c_) { nM = M / BM; nN = N / BM; nwg = nM * nN; G = G_; c = c_; }
    __host__ __device__ bool next(int i, Unit& u) const {
        const long L = (long)i * G + c; if (L >= nwg) return false;
        int wgid = (int)L; { const int q = nwg / NXCD, r = nwg % NXCD, xcd = wgid % NXCD, off = wgid / NXCD; wgid = (xcd < r ? xcd * (q + 1) : r * (q + 1) + (xcd - r) * q) + off; }
        const int nig = WGM * nN, gid = wgid / nig, fm = gid * WGM, gsz = (nM - fm) < WGM ? (nM - fm) : WGM;
        u.pm = fm + ((wgid % nig) % gsz); u.pn = (wgid % nig) / gsz; return true;
    }
};

template <class Epi, bool ALIGN_EPI>
__device__ __forceinline__ void gemm_phase(PG8_LAS unsigned char* lds, const Gemm g, const StaticOrder& S, const Epi& E) {
    const int tid = threadIdx.x, wid = __builtin_amdgcn_readfirstlane(tid >> 6), lane = tid & 63, wr = wid >> 2, wc = wid & 3, fr = lane & 15, fq = lane >> 4;
    const int K = g.K, nt = K / BK;
    unsigned voffA[2], voffB[2];
#pragma unroll
    for (int i = 0; i < 2; ++i) { int R, C; stage_rc(tid * 16 + i * 8192, R, C);
        const int Ra = Epi::ASIG ? (128 * (R >> 6) + (R & 63)) : R;
        const int Rb = (Epi::BMODE == 1) ? (64 * (R >> 5) + perm32(R & 31)) : (Epi::PERM ? ((R & ~31) + perm32(R & 31)) : R);
        voffA[i] = (unsigned)(Ra * K + C) * 2u; voffB[i] = (unsigned)(Rb * K + C) * 2u; }
    const size_t kstep = (size_t)(BK * 2);
    const size_t hstepA = Epi::ASIG ? (size_t)64 * K * 2 : (size_t)HALF * K * 2;
    const size_t hstepB = (Epi::BMODE == 1) ? (size_t)32 * K * 2 : ((Epi::BMODE == 2) ? g.bhalf : (size_t)HALF * K * 2);
    const size_t tstepA = (size_t)BM * K * 2;
    const size_t tstepB = (Epi::BMODE == 2) ? (size_t)HALF * K * 2 : (size_t)BM * K * 2;
    const unsigned ldsw = (unsigned)wid * 1024u;
    const int aoff = lds_byte(wr * 64 + fr, fq * 8), boff = lds_byte(wc * 32 + fr, fq * 8);
#define PG8_SA(b, h) (((b) * 2 + (h)) * HTB)
#define PG8_SB(b, h) ((4 + (b) * 2 + (h)) * HTB)
#define PG8_STAGE(bufoff, gbase, voff) do { _Pragma("unroll") for (int _i = 0; _i < 2; ++_i) \
        __builtin_amdgcn_global_load_lds((const unsigned*)((const char*)(gbase) + (voff)[_i]), (PG8_LAS unsigned*)(lds + (bufoff) + ldsw + _i * 8192), 16, 0, 0); } while (0)
#define PG8_LDA(dst, b, h) do { _Pragma("unroll") for (int m = 0; m < 4; ++m) _Pragma("unroll") for (int k = 0; k < 2; ++k) dst[m][k] = *(const PG8_LAS bf16x8*)(lds + PG8_SA(b, h) + aoff + m * 2048 + k * 1024); } while (0)
#define PG8_LDB(dst, b, h) do { _Pragma("unroll") for (int n = 0; n < 2; ++n) _Pragma("unroll") for (int k = 0; k < 2; ++k) dst[n][k] = *(const PG8_LAS bf16x8*)(lds + PG8_SB(b, h) + boff + n * 2048 + k * 1024); } while (0)
#define PG8_MMA(ai, bj, At, Bt) do { __builtin_amdgcn_s_setprio(1); _Pragma("unroll") for (int m = 0; m < 4; ++m) _Pragma("unroll") for (int n = 0; n < 2; ++n) _Pragma("unroll") for (int k = 0; k < 2; ++k) \
        acc[ai][bj][m][n] = __builtin_amdgcn_mfma_f32_16x16x32_bf16(Bt[n][k], At[m][k], acc[ai][bj][m][n], 0, 0, 0); __builtin_amdgcn_s_setprio(0); } while (0)
#define PG8_WAIT_V(n) asm volatile("s_waitcnt vmcnt(" #n ")" ::: "memory")
#define PG8_WAIT_L(n) asm volatile("s_waitcnt lgkmcnt(" #n ")" ::: "memory")
#define PG8_BAR __builtin_amdgcn_s_barrier()
#define PG8_SCHED __builtin_amdgcn_sched_barrier(0)
    Unit cur, nxt; int ui = 0;
    if (!S.next(0, cur)) return;
    f32x4 acc[2][2][4][2];
#pragma unroll
    for (int a = 0; a < 2; ++a)
#pragma unroll
        for (int b = 0; b < 2; ++b)
#pragma unroll
            for (int m = 0; m < 4; ++m)
#pragma unroll
                for (int n = 0; n < 2; ++n) acc[a][b][m][n] = (f32x4){0.f, 0.f, 0.f, 0.f};
    bf16x8 At[4][2], B0[2][2], B1[2][2];
    const char* cA = (const char*)g.A + (size_t)cur.pm * tstepA; const char* cB = (const char*)g.Bt + (size_t)cur.pn * tstepB;
    PG8_STAGE(PG8_SB(0, 0), cB, voffB); PG8_STAGE(PG8_SB(0, 1), cB + hstepB, voffB); PG8_STAGE(PG8_SA(0, 0), cA, voffA); PG8_STAGE(PG8_SA(0, 1), cA + hstepA, voffA);
    if (wr == 1) PG8_BAR;
    PG8_WAIT_V(2); PG8_BAR;
    PG8_STAGE(PG8_SB(1, 0), cB + kstep, voffB); PG8_STAGE(PG8_SA(1, 0), cA + kstep, voffA); PG8_STAGE(PG8_SB(1, 1), cB + hstepB + kstep, voffB);
    PG8_WAIT_V(6); PG8_BAR;
    for (;;) {
        const bool has_next = S.next(ui + 1, nxt);
        const char* nA = has_next ? (const char*)g.A + (size_t)nxt.pm * tstepA : cA; const char* nB = has_next ? (const char*)g.Bt + (size_t)nxt.pn * tstepB : cB;
        for (int t = 0; t < nt; t += 2) {
            const bool last = (t == nt - 2);
            const char* a1 = cA + (size_t)(t + 1) * kstep;
            const char* a2 = last ? nA : cA + (size_t)(t + 2) * kstep; const char* b2 = last ? nB : cB + (size_t)(t + 2) * kstep;
            const char* a3 = a2 + kstep; const char* b3 = b2 + kstep;
            PG8_LDB(B0, 0, 0); PG8_LDB(B1, 0, 1); PG8_SCHED; PG8_LDA(At, 0, 0); PG8_STAGE(PG8_SA(1, 1), a1 + hstepA, voffA);
            PG8_WAIT_V(8); PG8_WAIT_L(0); PG8_BAR; PG8_MMA(0, 0, At, B0); PG8_MMA(0, 1, At, B1); PG8_BAR; PG8_SCHED;
            PG8_LDA(At, 0, 1); PG8_STAGE(PG8_SB(0, 0), b2, voffB); PG8_STAGE(PG8_SB(0, 1), b2 + hstepB, voffB); PG8_STAGE(PG8_SA(0, 0), a2, voffA);
            PG8_WAIT_V(8); PG8_WAIT_L(0); PG8_BAR; PG8_MMA(1, 0, At, B0); PG8_MMA(1, 1, At, B1); PG8_BAR; PG8_SCHED;
            PG8_LDB(B0, 1, 0); PG8_LDB(B1, 1, 1); PG8_SCHED; PG8_LDA(At, 1, 0); PG8_STAGE(PG8_SA(0, 1), a2 + hstepA, voffA);
            PG8_WAIT_V(8); PG8_WAIT_L(0); PG8_BAR; PG8_MMA(0, 0, At, B0); PG8_MMA(0, 1, At, B1); PG8_BAR; PG8_SCHED;
            PG8_LDA(At, 1, 1); PG8_STAGE(PG8_SB(1, 0), b3, voffB); PG8_STAGE(PG8_SB(1, 1), b3 + hstepB, voffB); PG8_STAGE(PG8_SA(1, 0), a3, voffA);
            PG8_WAIT_V(8); PG8_WAIT_L(0); PG8_BAR; PG8_MMA(1, 0, At, B0); PG8_MMA(1, 1, At, B1); PG8_BAR; PG8_SCHED;
        }
        if constexpr (ALIGN_EPI) { if (wr == 0) PG8_BAR; }
        E(acc, cur, wr, wc, fr, fq);
        if (!has_next) break;
#pragma unroll
        for (int a = 0; a < 2; ++a)
#pragma unroll
            for (int b = 0; b < 2; ++b)
#pragma unroll
                for (int m = 0; m < 4; ++m)
#pragma unroll
                    for (int n = 0; n < 2; ++n) acc[a][b][m][n] = (f32x4){0.f, 0.f, 0.f, 0.f};
        cur = nxt; cA = nA; cB = nB; ++ui;
        if constexpr (ALIGN_EPI) { if (wr == 1) PG8_BAR; }
    }
    PG8_WAIT_V(0);
    if constexpr (!ALIGN_EPI) { if (wr == 0) PG8_BAR; }
    PG8_BAR;
#undef PG8_SA
#undef PG8_SB
#undef PG8_STAGE
#undef PG8_LDA
#undef PG8_LDB
#undef PG8_MMA
#undef PG8_WAIT_V
#undef PG8_WAIT_L
#undef PG8_BAR
#undef PG8_SCHED
}
}

__device__ __forceinline__ unsigned cvt_pk_bf16(float lo, float hi) { unsigned r; asm volatile("v_cvt_pk_bf16_f32 %0, %1, %2" : "=v"(r) : "v"(lo), "v"(hi)); return r; }

struct EpiInProj {
    static constexpr bool PERM = true, ASIG = false; static constexpr int BMODE = 1;
    bf16_t* base; const float* qg; const float* kg;
    __device__ __forceinline__ void operator()(const f32x4 (&acc)[2][2][4][2], const pg8::Unit& u, int wr, int wc, int fr, int fq) const {
        const int gc0 = u.pn * 256, seg = gc0 >> 9, cb = (gc0 & 511) + 64 * wc + 8 * fq;
        bf16_t* O = base + (size_t)seg * ((size_t)MTOK * 512) + cb;
        const int row0 = u.pm * 256 + wr * 64 + fr;
        if (seg == 2 || seg == 3) {
            const float* gp = (seg == 2) ? qg : kg; const float sc = (seg == 2) ? C2 : 1.0f;
            f32x4 gv[2][2];
#pragma unroll
            for (int bj = 0; bj < 2; ++bj)
#pragma unroll
                for (int n = 0; n < 2; ++n) gv[bj][n] = *(const f32x4*)(gp + 32 * bj + 8 * fq + 4 * n) * sc;
#pragma unroll
            for (int ai = 0; ai < 2; ++ai)
#pragma unroll
                for (int m = 0; m < 4; ++m) {
                    float ss = 0.f;
#pragma unroll
                    for (int bj = 0; bj < 2; ++bj)
#pragma unroll
                        for (int n = 0; n < 2; ++n) { const f32x4 x = acc[ai][bj][m][n]; ss += (x[0] * x[0] + x[1] * x[1]) + (x[2] * x[2] + x[3] * x[3]); }
                    ss += __shfl_xor(ss, 16); ss += __shfl_xor(ss, 32);
                    const float rstd = rsqrtf(ss * (1.0f / 64.0f) + EPS);
                    bf16_t* rowp = O + (size_t)(row0 + ai * 128 + m * 16) * 512;
#pragma unroll
                    for (int bj = 0; bj < 2; ++bj) { const f32x4 v0 = acc[ai][bj][m][0] * rstd * gv[bj][0], v1 = acc[ai][bj][m][1] * rstd * gv[bj][1];
                        u32x4 w; w.x = cvt_pk_bf16(v0[0], v0[1]); w.y = cvt_pk_bf16(v0[2], v0[3]); w.z = cvt_pk_bf16(v1[0], v1[1]); w.w = cvt_pk_bf16(v1[2], v1[3]);
                        *(u32x4*)(rowp + 32 * bj) = w; }
                }
        } else {
#pragma unroll
            for (int ai = 0; ai < 2; ++ai)
#pragma unroll
                for (int m = 0; m < 4; ++m) { bf16_t* rowp = O + (size_t)(row0 + ai * 128 + m * 16) * 512;
#pragma unroll
                    for (int bj = 0; bj < 2; ++bj) { const f32x4 v0 = acc[ai][bj][m][0], v1 = acc[ai][bj][m][1];
                        u32x4 w; w.x = cvt_pk_bf16(v0[0], v0[1]); w.y = cvt_pk_bf16(v0[2], v0[3]); w.z = cvt_pk_bf16(v1[0], v1[1]); w.w = cvt_pk_bf16(v1[2], v1[3]);
                        *(u32x4*)(rowp + 32 * bj) = w; } }
        }
    }
};
struct EpiBf16Plain {
    static constexpr bool PERM = true, ASIG = false; static constexpr int BMODE = 0;
    bf16_t* O; long ldc;
    __device__ __forceinline__ void operator()(const f32x4 (&acc)[2][2][4][2], const pg8::Unit& u, int wr, int wc, int fr, int fq) const {
        const int row0 = u.pm * 256 + wr * 64 + fr, col0 = u.pn * 256 + wc * 32 + 8 * fq;
#pragma unroll
        for (int ai = 0; ai < 2; ++ai)
#pragma unroll
            for (int m = 0; m < 4; ++m) { bf16_t* rowp = O + (size_t)(row0 + ai * 128 + m * 16) * ldc + col0;
#pragma unroll
                for (int bj = 0; bj < 2; ++bj) { const f32x4 v0 = acc[ai][bj][m][0], v1 = acc[ai][bj][m][1];
                    u32x4 w; w.x = cvt_pk_bf16(v0[0], v0[1]); w.y = cvt_pk_bf16(v0[2], v0[3]); w.z = cvt_pk_bf16(v1[0], v1[1]); w.w = cvt_pk_bf16(v1[2], v1[3]);
                    *(u32x4*)(rowp + bj * 128) = w; } }
    }
};
struct EpiResid {
    static constexpr bool PERM = false, ASIG = false; static constexpr int BMODE = 0;
    const float* base; float* out; bf16_t* xb; float* ss;
    __device__ __forceinline__ void operator()(const f32x4 (&acc)[2][2][4][2], const pg8::Unit& u, int wr, int wc, int fr, int fq) const {
        const int col0 = u.pn * 256 + wc * 32 + 4 * fq;
#pragma unroll
        for (int ai = 0; ai < 2; ++ai)
#pragma unroll
            for (int m = 0; m < 4; ++m) { const int row = u.pm * 256 + ai * 128 + wr * 64 + m * 16 + fr; const size_t off = (size_t)row * DM + col0; float s = 0.f;
#pragma unroll
                for (int bj = 0; bj < 2; ++bj)
#pragma unroll
                    for (int n = 0; n < 2; ++n) { const f32x4 bs = *(const f32x4*)(base + off + bj * 128 + n * 16); const f32x4 o = bs + acc[ai][bj][m][n];
                        *(f32x4*)(out + off + bj * 128 + n * 16) = o; s += (o[0] * o[0] + o[1] * o[1]) + (o[2] * o[2] + o[3] * o[3]);
                        u32x2 w; w.x = cvt_pk_bf16(o[0], o[1]); w.y = cvt_pk_bf16(o[2], o[3]); *(u32x2*)(xb + off + bj * 128 + n * 16) = w; }
                s += __shfl_xor(s, 16); s += __shfl_xor(s, 32);
                if (fq == 0) ss[(size_t)row * 16 + u.pn * 4 + wc] = s; }
    }
};
__device__ __forceinline__ float row_rstd(const float* ss, int row, int fq) {
    const f32x4 p = *(const f32x4*)(ss + (size_t)row * 16 + 4 * fq); float s = (p[0] + p[1]) + (p[2] + p[3]);
    s += __shfl_xor(s, 16); s += __shfl_xor(s, 32); return rsqrtf(s * (1.0f / DM) + EPS);
}
struct EpiUpRaw {
    static constexpr bool PERM = true, ASIG = false; static constexpr int BMODE = 2;
    bf16_t* G; bf16_t* V; const float* ss;
    __device__ __forceinline__ void operator()(const f32x4 (&acc)[2][2][4][2], const pg8::Unit& u, int wr, int wc, int fr, int fq) const {
        const int col0 = u.pn * 128 + wc * 32 + 8 * fq;
#pragma unroll
        for (int ai = 0; ai < 2; ++ai)
#pragma unroll
            for (int m = 0; m < 4; ++m) { const int row = u.pm * 256 + ai * 128 + wr * 64 + m * 16 + fr; const float rstd = row_rstd(ss, row, fq);
                { const f32x4 v0 = acc[ai][0][m][0] * rstd, v1 = acc[ai][0][m][1] * rstd; u32x4 w; w.x = cvt_pk_bf16(v0[0], v0[1]); w.y = cvt_pk_bf16(v0[2], v0[3]); w.z = cvt_pk_bf16(v1[0], v1[1]); w.w = cvt_pk_bf16(v1[2], v1[3]);
                  *(u32x4*)(G + (size_t)row * DFF + col0) = w; }
                { const f32x4 v0 = acc[ai][1][m][0] * rstd, v1 = acc[ai][1][m][1] * rstd; u32x4 w; w.x = cvt_pk_bf16(v0[0], v0[1]); w.y = cvt_pk_bf16(v0[2], v0[3]); w.z = cvt_pk_bf16(v1[0], v1[1]); w.w = cvt_pk_bf16(v1[2], v1[3]);
                  *(u32x4*)(V + (size_t)row * DFF + col0) = w; } }
    }
};
struct EpiFinal {
    static constexpr bool PERM = false, ASIG = false; static constexpr int BMODE = 0;
    float* out; const bf16_t* prj; const float* ss;
    __device__ __forceinline__ void operator()(const f32x4 (&acc)[2][2][4][2], const pg8::Unit& u, int wr, int wc, int fr, int fq) const {
        const int col0 = u.pn * 256 + wc * 32 + 4 * fq;
#pragma unroll
        for (int ai = 0; ai < 2; ++ai)
#pragma unroll
            for (int m = 0; m < 4; ++m) { const int row = u.pm * 256 + ai * 128 + wr * 64 + m * 16 + fr; const size_t off = (size_t)row * DM + col0; const float rstd = row_rstd(ss, row, fq);
#pragma unroll
                for (int bj = 0; bj < 2; ++bj)
#pragma unroll
                    for (int n = 0; n < 2; ++n) { const f32x4 h2 = *(const f32x4*)(out + off + bj * 128 + n * 16); const u32x2 pw = *(const u32x2*)(prj + off + bj * 128 + n * 16);
                        const f32x4 a = acc[ai][bj][m][n] * rstd; f32x4 o;
                        o[0] = h2[0] + sigmoidf_(a[0]) * bf2f(pw.x & 0xffffu); o[1] = h2[1] + sigmoidf_(a[1]) * bf2f(pw.x >> 16);
                        o[2] = h2[2] + sigmoidf_(a[2]) * bf2f(pw.y & 0xffffu); o[3] = h2[3] + sigmoidf_(a[3]) * bf2f(pw.y >> 16);
                        *(f32x4*)(out + off + bj * 128 + n * 16) = o; } }
    }
};

constexpr int GEMM_LDS = 147456;
template <class Epi, bool ALIGN>
__global__ void __launch_bounds__(512, 2) gemm_kernel(pg8::Gemm g, Epi E) {
    extern __shared__ __attribute__((aligned(16))) unsigned char lds[];
    pg8::StaticOrder S; S.init(g.M, g.N, (int)gridDim.x, (int)blockIdx.x);
    pg8::gemm_phase<Epi, ALIGN>((PG8_LAS unsigned char*)lds, g, S, E);
}

__global__ void __launch_bounds__(256) k_transpose(const float* __restrict__ W, int K, int N, bf16_t* __restrict__ WT, const float* __restrict__ gain) {
    __shared__ float tile[32][33];
    const int n0 = blockIdx.x * 32, k0 = blockIdx.y * 32, tx = threadIdx.x & 31, ty = threadIdx.x >> 5;
#pragma unroll
    for (int j = 0; j < 4; ++j) { const int k = k0 + ty + 8 * j; tile[ty + 8 * j][tx] = W[(size_t)k * N + n0 + tx] * (gain ? gain[k] : 1.0f); }
    __syncthreads();
#pragma unroll
    for (int j = 0; j < 4; ++j) { const int n = n0 + ty + 8 * j; WT[(size_t)n * K + k0 + tx] = (bf16_t)f2bf(tile[tx][ty + 8 * j]); }
}
__device__ __forceinline__ float wave_sum(float v) {
#pragma unroll
    for (int o = 1; o < 64; o <<= 1) v += __shfl_xor(v, o);
    return v;
}
__device__ __forceinline__ float wave_max(float v) {
#pragma unroll
    for (int o = 1; o < 64; o <<= 1) v = fmaxf(v, __shfl_xor(v, o));
    return v;
}
__global__ void __launch_bounds__(256) k_rmsnorm(const float* __restrict__ x, const float* __restrict__ g, bf16_t* __restrict__ xn) {
    const int row = blockIdx.x * 4 + (threadIdx.x >> 6), lane = threadIdx.x & 63;
    const f32x4* xr = (const f32x4*)(x + (size_t)row * DM) + lane; const f32x4* gr = (const f32x4*)g + lane;
    f32x4 v[4]; float s = 0.f;
#pragma unroll
    for (int j = 0; j < 4; ++j) { v[j] = xr[64 * j]; s += (v[j][0] * v[j][0] + v[j][1] * v[j][1]) + (v[j][2] * v[j][2] + v[j][3] * v[j][3]); }
    const float rstd = rsqrtf(wave_sum(s) * (1.0f / DM) + EPS);
    unsigned long long* o8 = (unsigned long long*)(xn + (size_t)row * DM) + lane;
#pragma unroll
    for (int j = 0; j < 4; ++j) { const f32x4 gg = gr[64 * j]; o8[64 * j] = (unsigned long long)pk2(v[j][0] * rstd * gg[0], v[j][1] * rstd * gg[1]) | ((unsigned long long)pk2(v[j][2] * rstd * gg[2], v[j][3] * rstd * gg[3]) << 32); }
}
__global__ void __launch_bounds__(256) k_cvt_bf16(const float* __restrict__ src, bf16_t* __restrict__ dst, size_t n4) {
    size_t i = (size_t)blockIdx.x * 256 + threadIdx.x;
    for (; i < n4; i += (size_t)gridDim.x * 256) { const f32x4 v = ((const f32x4*)src)[i]; ((unsigned long long*)dst)[i] = (unsigned long long)pk2(v[0], v[1]) | ((unsigned long long)pk2(v[2], v[3]) << 32); }
}
__global__ void __launch_bounds__(64) k_kmean(const bf16_t* __restrict__ Kb, float* __restrict__ KM) {
    const int blk = blockIdx.x, n = blk & 15, h = (blk >> 4) & 7, b = blk >> 7, d = threadIdx.x;
    const bf16_t* p = Kb + ((size_t)b * SEQ + n * 256) * 512 + h * 64 + d; float s = 0.f;
    for (int r = 0; r < 256; ++r) s += bf2f(p[(size_t)r * 512]);
    KM[(size_t)blk * 64 + d] = s * (1.0f / 256.0f);
}
__global__ void __launch_bounds__(256) k_attn_naive(const bf16_t* __restrict__ Q, const bf16_t* __restrict__ Kb, const bf16_t* __restrict__ Vb, const float* __restrict__ KM, bf16_t* __restrict__ Y) {
    const int wave = (int)((blockIdx.x * 256u + threadIdx.x) >> 6), lane = threadIdx.x & 63;
    const int t = wave & 4095, bh = wave >> 12, h = bh & 7, b = bh >> 3, qb = t >> 8;
    const size_t rowq = (size_t)b * SEQ + t;
    const float myq = bf2f(Q[rowq * 512 + h * 64 + lane]);
    float qs[64];
#pragma unroll
    for (int d = 0; d < 64; ++d) qs[d] = __shfl(myq, d);
    const float slope2 = exp2f(-(float)(h + 1)) * LOG2E;
    float gate = -3.0e38f;
    if (lane < 16 && lane < qb) { const float* km = KM + ((size_t)bh * 16 + lane) * 64; float g = 0.f;
#pragma unroll
        for (int d = 0; d < 64; ++d) g += qs[d] * km[d];
        gate = g; }
    int sel[3];
#pragma unroll
    for (int s = 0; s < 3; ++s) { const float mx = wave_max(gate); const unsigned long long bal = __ballot(gate == mx); const int idx = __ffsll((long long)bal) - 1; sel[s] = idx; if (lane == idx) gate = -INFINITY; }
    const int nsel = qb < 3 ? qb : 3;
    float lg[4][4];
#pragma unroll
    for (int bi = 0; bi < 4; ++bi) {
        const bool own = (bi == 3); const bool act = own || (bi < nsel);
        const int blk = own ? qb : sel[bi < 3 ? bi : 0];
#pragma unroll
        for (int i = 0; i < 4; ++i) {
            float v = -INFINITY;
            if (act) { const int s = blk * 256 + 64 * i + lane;
                if (!own || s <= t) { const u32x4* kp = (const u32x4*)(Kb + ((size_t)b * SEQ + s) * 512 + h * 64); float dsum = 0.f;
#pragma unroll
                    for (int c = 0; c < 8; ++c) { const u32x4 w = kp[c];
                        dsum += qs[8 * c + 0] * bf2f(w.x & 0xffffu) + qs[8 * c + 1] * bf2f(w.x >> 16) + qs[8 * c + 2] * bf2f(w.y & 0xffffu) + qs[8 * c + 3] * bf2f(w.y >> 16)
                              + qs[8 * c + 4] * bf2f(w.z & 0xffffu) + qs[8 * c + 5] * bf2f(w.z >> 16) + qs[8 * c + 6] * bf2f(w.w & 0xffffu) + qs[8 * c + 7] * bf2f(w.w >> 16); }
                    v = dsum - slope2 * (float)(t - s); } }
            lg[bi][i] = v; }
    }
    float mx = -INFINITY;
#pragma unroll
    for (int bi = 0; bi < 4; ++bi)
#pragma unroll
        for (int i = 0; i < 4; ++i) mx = fmaxf(mx, lg[bi][i]);
    mx = wave_max(mx);
    float lsum = 0.f;
#pragma unroll
    for (int bi = 0; bi < 4; ++bi)
#pragma unroll
        for (int i = 0; i < 4; ++i) { lg[bi][i] = exp2f(lg[bi][i] - mx); lsum += lg[bi][i]; }
    lsum = wave_sum(lsum);
    float o = 0.f;
#pragma unroll
    for (int bi = 0; bi < 4; ++bi) {
        const bool own = (bi == 3); const bool act = own || (bi < nsel);
        if (act) { const int blk = own ? qb : sel[bi < 3 ? bi : 0];
#pragma unroll
            for (int i = 0; i < 4; ++i) { const int s0 = blk * 256 + 64 * i; int cnt = 64; if (own) { cnt = t - s0 + 1; cnt = cnt < 0 ? 0 : (cnt > 64 ? 64 : cnt); }
                const bf16_t* vp = Vb + ((size_t)b * SEQ + s0) * 512 + h * 64 + lane; const float pv = lg[bi][i];
                for (int j = 0; j < cnt; ++j) o += __shfl(pv, j) * bf2f(vp[(size_t)j * 512]); } }
    }
    Y[rowq * DM + 512 + h * 64 + lane] = (bf16_t)f2bf(o / lsum);
}
__global__ void __launch_bounds__(256) k_lru_gates(const bf16_t* __restrict__ XL, const float* __restrict__ cw, const float* __restrict__ cb, const float* __restrict__ wa, const float* __restrict__ ba,
                                                   const float* __restrict__ wx, const float* __restrict__ bx, const float* __restrict__ lam, float* __restrict__ Aout, float* __restrict__ Bout) {
    const int wave = (int)((blockIdx.x * 256u + threadIdx.x) >> 6), lane = threadIdx.x & 63;
    const int n = wave & 7, m = wave >> 3, t = m & (SEQ - 1), c = n * 64 + lane;
    float xc = cb[c];
#pragma unroll
    for (int k = 0; k < 4; ++k) { const int tt = t - 3 + k; if (tt >= 0) xc += cw[k * LRU_W + c] * bf2f(XL[(size_t)(m - 3 + k) * 512 + c]); }
    float ra = ba[c], rx = bx[c];
    const float* wap = wa + (size_t)n * 4096 + lane; const float* wxp = wx + (size_t)n * 4096 + lane;
#pragma unroll 8
    for (int cc = 0; cc < 64; ++cc) { const float xs = __shfl(xc, cc); ra += xs * wap[cc * 64]; rx += xs * wxp[cc * 64]; }
    const float r = sigmoidf_(ra), ig = sigmoidf_(rx);
    const float sp = log1pf(expf(-lam[c]));
    const float log_a = -8.0f * r * sp;
    const float a = expf(log_a);
    float mult = sqrtf(-expm1f(2.0f * log_a)); if (t == 0) mult = 1.0f;
    Aout[(size_t)m * 512 + c] = a; Bout[(size_t)m * 512 + c] = mult * ig * xc;
}
__global__ void __launch_bounds__(64) k_lru_scan(const float* __restrict__ Ain, const float* __restrict__ Bin, const bf16_t* __restrict__ GL, bf16_t* __restrict__ Y) {
    const int idx = blockIdx.x * 64 + threadIdx.x, c = idx & 511, b = idx >> 9;
    float h = 0.f;
    for (int t = 0; t < SEQ; ++t) { const size_t m = (size_t)b * SEQ + t; h = Ain[m * 512 + c] * h + Bin[m * 512 + c];
        Y[m * DM + c] = (bf16_t)f2bf(h * gelu_tanh(bf2f(GL[m * 512 + c]))); }
}
__global__ void __launch_bounds__(256) k_ffn_conv(const bf16_t* __restrict__ G, const bf16_t* __restrict__ V, const float* __restrict__ cw, const float* __restrict__ cb, bf16_t* __restrict__ ACT, int rows) {
    const size_t i = (size_t)blockIdx.x * 256 + threadIdx.x;
    const int cg = (int)(i % (DFF / 8)), row = (int)(i / (DFF / 8)); if (row >= rows) return;
    const int t = row & (SEQ - 1), j0 = cg * 8;
    const u32x4 g0 = *(const u32x4*)(G + (size_t)row * DFF + j0);
    u32x4 g1 = {0, 0, 0, 0}, g2 = {0, 0, 0, 0};
    if (t >= 1) g1 = *(const u32x4*)(G + (size_t)(row - 1) * DFF + j0);
    if (t >= 2) g2 = *(const u32x4*)(G + (size_t)(row - 2) * DFF + j0);
    const u32x4 vv = *(const u32x4*)(V + (size_t)row * DFF + j0);
    unsigned ow[4];
#pragma unroll
    for (int q = 0; q < 4; ++q) {
        const unsigned a0 = g0[q], a1 = g1[q], a2 = g2[q], av = vv[q]; float r2[2];
#pragma unroll
        for (int e = 0; e < 2; ++e) { const int j = j0 + 2 * q + e;
            const float x0 = bf2f(e ? (a0 >> 16) : (a0 & 0xffffu)), x1 = bf2f(e ? (a1 >> 16) : (a1 & 0xffffu)), x2 = bf2f(e ? (a2 >> 16) : (a2 & 0xffffu)), xv = bf2f(e ? (av >> 16) : (av & 0xffffu));
            const float pre = cw[j] * x2 + cw[DFF + j] * x1 + cw[2 * DFF + j] * x0 + cb[j];
            r2[e] = gelu_tanh(pre) * xv; }
        ow[q] = pk2(r2[0], r2[1]); }
    *(u32x4*)(ACT + (size_t)row * DFF + j0) = (u32x4){ow[0], ow[1], ow[2], ow[3]};
}

constexpr size_t MiB = 1u << 20;
constexpr size_t WS_KM = 1 * MiB, WS_SS1 = 2 * MiB, WS_SS2 = 4 * MiB;
constexpr size_t WS_WIN = 8 * MiB, WS_WOUT = 13 * MiB, WS_WUP = 15 * MiB, WS_WDN = 27 * MiB, WS_WG = 33 * MiB, WS_WP = 35 * MiB;
constexpr size_t WS_XN = 40 * MiB;
constexpr size_t WS_PB = 104 * MiB;
constexpr size_t WS_R = 184 * MiB;
constexpr size_t WS_ACT = WS_R + 64 * MiB;
constexpr size_t WS_PRJ = 440 * MiB;
constexpr size_t WS_LA = WS_R + 160 * MiB, WS_LB = WS_R + 224 * MiB;
constexpr size_t WS_UPG = 40 * MiB, WS_UPV = 88 * MiB;
constexpr size_t WS_END = 512 * MiB;

template <class Epi, bool ALIGN>
static void launch_gemm(const pg8::Gemm& g, const Epi& E, hipStream_t stream) {
    static bool attr_done = false;
    if (!attr_done) { (void)hipFuncSetAttribute((const void*)gemm_kernel<Epi, ALIGN>, hipFuncAttributeMaxDynamicSharedMemorySize, GEMM_LDS); attr_done = true; }
    hipLaunchKernelGGL((gemm_kernel<Epi, ALIGN>), dim3(256), dim3(512), GEMM_LDS, stream, g, E);
}

extern "C" void kernel_launch(void* const* d_in, const int* in_sizes, int n_in, void* d_out, int out_size, void* d_ws, size_t ws_size, hipStream_t stream) {
    if (n_in != 22 || ws_size < WS_END) { fprintf(stderr, "kernel_launch: unexpected n_in %d or ws_size %zu\n", n_in, ws_size); return; }
    const float* x = (const float*)d_in[0]; const float* p = (const float*)d_in[1]; const float* ln_mix = (const float*)d_in[2]; const float* w_in = (const float*)d_in[3];
    const float* conv_w = (const float*)d_in[4]; const float* conv_b = (const float*)d_in[5]; const float* gaw = (const float*)d_in[6]; const float* gab = (const float*)d_in[7];
    const float* gxw = (const float*)d_in[8]; const float* gxb = (const float*)d_in[9]; const float* lam = (const float*)d_in[10]; const float* q_gain = (const float*)d_in[11];
    const float* k_gain = (const float*)d_in[12]; const float* w_out = (const float*)d_in[13]; const float* ln_ffn = (const float*)d_in[14]; const float* w_up = (const float*)d_in[15];
    const float* fcw = (const float*)d_in[16]; const float* fcb = (const float*)d_in[17]; const float* w_down = (const float*)d_in[18]; const float* ln_ple = (const float*)d_in[19];
    const float* w_g = (const float*)d_in[20]; const float* w_p = (const float*)d_in[21];
    unsigned char* ws = (unsigned char*)d_ws; float* out = (float*)d_out;
    bf16_t* WT_in = (bf16_t*)(ws + WS_WIN); bf16_t* WT_out = (bf16_t*)(ws + WS_WOUT); bf16_t* WT_up = (bf16_t*)(ws + WS_WUP); bf16_t* WT_dn = (bf16_t*)(ws + WS_WDN);
    bf16_t* WT_g = (bf16_t*)(ws + WS_WG); bf16_t* WT_p = (bf16_t*)(ws + WS_WP);
    bf16_t* XN = (bf16_t*)(ws + WS_XN); bf16_t* PB = (bf16_t*)(ws + WS_PB); bf16_t* PRJ = (bf16_t*)(ws + WS_PRJ);
    bf16_t* XL = (bf16_t*)(ws + WS_R); bf16_t* GL = XL + (size_t)MTOK * 512; bf16_t* Qb = GL + (size_t)MTOK * 512; bf16_t* Kb = Qb + (size_t)MTOK * 512; bf16_t* Vb = Kb + (size_t)MTOK * 512;
    bf16_t* Y = XN; bf16_t* XB1 = (bf16_t*)(ws + WS_R); bf16_t* XB2 = XN; bf16_t* ACT = (bf16_t*)(ws + WS_ACT);
    float* KM = (float*)(ws + WS_KM); float* SS1 = (float*)(ws + WS_SS1); float* SS2 = (float*)(ws + WS_SS2);
    float* LA = (float*)(ws + WS_LA); float* LB = (float*)(ws + WS_LB);

    hipLaunchKernelGGL(k_transpose, dim3(INW / 32, DM / 32), dim3(256), 0, stream, w_in, DM, INW, WT_in, (const float*)nullptr);
    hipLaunchKernelGGL(k_transpose, dim3(DM / 32, DM / 32), dim3(256), 0, stream, w_out, DM, DM, WT_out, (const float*)nullptr);
    hipLaunchKernelGGL(k_transpose, dim3(2 * DFF / 32, DM / 32), dim3(256), 0, stream, w_up, DM, 2 * DFF, WT_up, ln_ffn);
    hipLaunchKernelGGL(k_transpose, dim3(DM / 32, DFF / 32), dim3(256), 0, stream, w_down, DFF, DM, WT_dn, (const float*)nullptr);
    hipLaunchKernelGGL(k_transpose, dim3(DM / 32, DM / 32), dim3(256), 0, stream, w_g, DM, DM, WT_g, ln_ple);
    hipLaunchKernelGGL(k_transpose, dim3(DM / 32, PLE / 32), dim3(256), 0, stream, w_p, PLE, DM, WT_p, (const float*)nullptr);
    hipLaunchKernelGGL(k_rmsnorm, dim3(MTOK / 4), dim3(256), 0, stream, x, ln_mix, XN);
    hipLaunchKernelGGL(k_cvt_bf16, dim3(2048), dim3(256), 0, stream, p, PB, (size_t)MTOK * PLE / 4);
    { pg8::Gemm g{XN, WT_in, 0, MTOK, INW, DM, 0}; EpiInProj E{XL, q_gain, k_gain}; launch_gemm<EpiInProj, true>(g, E, stream); }
    hipLaunchKernelGGL(k_kmean, dim3(BATCH * NH * 16), dim3(64), 0, stream, Kb, KM);
    hipLaunchKernelGGL(k_attn_naive, dim3(BATCH * NH * SEQ / 4), dim3(256), 0, stream, Qb, Kb, Vb, KM, Y);
    hipLaunchKernelGGL(k_lru_gates, dim3(MTOK * 8 / 4), dim3(256), 0, stream, XL, conv_w, conv_b, gaw, gab, gxw, gxb, lam, LA, LB);
    hipLaunchKernelGGL(k_lru_scan, dim3(BATCH * 512 / 64), dim3(64), 0, stream, LA, LB, GL, Y);
    { pg8::Gemm g{Y, WT_out, 0, MTOK, DM, DM, 0}; EpiResid E{x, out, XB1, SS1}; launch_gemm<EpiResid, true>(g, E, stream); }
    { pg8::Gemm g{PB, WT_p, 0, MTOK, DM, PLE, 0}; EpiBf16Plain E{PRJ, (long)DM}; launch_gemm<EpiBf16Plain, true>(g, E, stream); }
    for (int q = 0; q < 4; ++q) {
        const size_t r0 = (size_t)q * (MTOK / 4);
        bf16_t* UPG = (bf16_t*)(ws + WS_UPG); bf16_t* UPV = (bf16_t*)(ws + WS_UPV);
        pg8::Gemm g{XB1 + r0 * DM, WT_up, (size_t)DFF * DM * 2, MTOK / 4, 2 * DFF, DM, 0}; EpiUpRaw E{UPG, UPV, SS1 + r0 * 16};
        launch_gemm<EpiUpRaw, true>(g, E, stream);
        const size_t nthr = (size_t)(MTOK / 4) * (DFF / 8);
        hipLaunchKernelGGL(k_ffn_conv, dim3((unsigned)((nthr + 255) / 256)), dim3(256), 0, stream, UPG, UPV, fcw, fcb, ACT + r0 * DFF, MTOK / 4);
    }
    { pg8::Gemm g{ACT, WT_dn, 0, MTOK, DM, DFF, 0}; EpiResid E{out, out, XB2, SS2}; launch_gemm<EpiResid, true>(g, E, stream); }
    { pg8::Gemm g{XB2, WT_g, 0, MTOK, DM, DM, 0}; EpiFinal E{out, PRJ, SS2}; launch_gemm<EpiFinal, true>(g, E, stream); }
}
```

```cpp
#include <hip/hip_runtime.h>
#include <cstdio>
#include <cstdint>

constexpr int BATCH = 8, SEQ = 4096, DM = 1024, MTOK = BATCH * SEQ;
constexpr int LRU_W = 512, ATT_W = 512, NH = 8, HD = 64, INW = 2560, DFF = 3072, PLE = 256;
constexpr float EPS = 1e-6f;
constexpr float LOG2E = 1.4426950408889634f;
constexpr float C2 = 0.125f * LOG2E;

typedef unsigned short bf16_t;
typedef short bf16x8 __attribute__((ext_vector_type(8)));
typedef float f32x4 __attribute__((ext_vector_type(4)));
typedef float f32x2 __attribute__((ext_vector_type(2)));
typedef unsigned u32x4 __attribute__((ext_vector_type(4)));
typedef unsigned u32x2 __attribute__((ext_vector_type(2)));

__device__ __forceinline__ unsigned f2bf(float f) { unsigned u = __builtin_bit_cast(unsigned, f); return (u + 0x7fffu + ((u >> 16) & 1u)) >> 16; }
__device__ __forceinline__ unsigned pk2(float lo, float hi) { return f2bf(lo) | (f2bf(hi) << 16); }
__device__ __forceinline__ float bf2f(unsigned v) { return __builtin_bit_cast(float, v << 16); }
__device__ __forceinline__ float gelu_tanh(float x) {
    const float u2 = x * (-1.5957691216f * LOG2E - 0.0713548163f * LOG2E * x * x);
    return x * __builtin_amdgcn_rcpf(1.0f + __builtin_amdgcn_exp2f(u2));
}
__device__ __forceinline__ float sigmoidf_(float x) { return __builtin_amdgcn_rcpf(1.0f + __builtin_amdgcn_exp2f(-LOG2E * x)); }

namespace pg8 {
#define PG8_LAS __attribute__((address_space(3)))
constexpr int BM = 256, BK = 64, HALF = 128, HTB = HALF * BK * 2, STAGE_BYTES = 8 * HTB, NXCD = 8, WGM = 8;

__host__ __device__ __forceinline__ int lds_byte(int r, int c) { const int st = (r >> 4) * 2 + (c >> 5), rr = r & 15, cc = c & 31, ob = rr * 64 + cc * 2; return st * 1024 + (ob ^ (((ob >> 9) & 1) << 5)); }
__host__ __device__ __forceinline__ void stage_rc(int b, int& R, int& C) { const int st = b / 1024, sb = b % 1024, swz = sb ^ (((sb >> 9) & 1) << 5); R = (st >> 1) * 16 + swz / 64; C = (st & 1) * 32 + (swz % 64) / 2; }
__host__ __device__ __forceinline__ int perm32(int rho) { const int n = rho >> 4, i = rho & 15; return 8 * (i >> 2) + 4 * n + (i & 3); }

struct Unit { int pm, pn; };
struct Gemm { const bf16_t* A; const bf16_t* Bt; size_t bhalf; int M, N, K, pad; };

struct StaticOrder {
    int nM, nN, nwg, G, c;
    __host__ __device__ void init(int M, int N, int G_, int c_) { nM = M / BM; nN = N / BM; nwg = nM * nN; G = G_; c = c_; }
    __host__ __device__ bool next(int i, Unit& u) const {
        const long L = (long)i * G + c; if (L >= nwg) return false;
        int wgid = (int)L; { const int q = nwg / NXCD, r = nwg % NXCD, xcd = wgid % NXCD, off = wgid / NXCD; wgid = (xcd < r ? xcd * (q + 1) : r * (q + 1) + (xcd - r) * q) + off; }
        const int nig = WGM * nN, gid = wgid / nig, fm = gid * WGM, gsz = (nM - fm) < WGM ? (nM - fm) : WGM;
        u.pm = fm + ((wgid % nig) % gsz); u.pn = (wgid % nig) / gsz; return true;
    }
};

template <class Epi, bool ALIGN_EPI>
__device__ __forceinline__ void gemm_phase(PG8_LAS unsigned char* lds, const Gemm g, const StaticOrder& S, const Epi& E, const int tid) {
    const int wid = __builtin_amdgcn_readfirstlane(tid >> 6), lane = tid & 63, wr = wid >> 2, wc = wid & 3, fr = lane & 15, fq = lane >> 4;
    const int K = g.K, nt = K / BK;
    unsigned voffA[2], voffB[2];
#pragma unroll
    for (int i = 0; i < 2; ++i) { int R, C; stage_rc(tid * 16 + i * 8192, R, C);
        const int Ra = Epi::ASIG ? (128 * (R >> 6) + 8 * (R & 15) + ((R >> 4) & 3)) : R;
        const int Rb = (Epi::BMODE == 1) ? (64 * (R >> 5) + perm32(R & 31)) : (Epi::PERM ? ((R & ~31) + perm32(R & 31)) : R);
        voffA[i] = (unsigned)(Ra * K + C) * 2u; voffB[i] = (unsigned)(Rb * K + C) * 2u; }
    const size_t kstep = (size_t)(BK * 2);
    const size_t hstepA = Epi::ASIG ? (size_t)4 * K * 2 : (size_t)HALF * K * 2;
    const size_t hstepB = (Epi::BMODE == 1) ? (size_t)32 * K * 2 : ((Epi::BMODE == 2) ? g.bhalf : (size_t)HALF * K * 2);
    const size_t tstepA = (size_t)BM * K * 2;
    const size_t tstepB = (Epi::BMODE == 2) ? (size_t)HALF * K * 2 : (size_t)BM * K * 2;
    const unsigned ldsw = (unsigned)wid * 1024u;
    const int aoff = lds_byte(wr * 64 + fr, fq * 8), boff = lds_byte(wc * 32 + fr, fq * 8);
#define PG8_SA(b, h) (((b) * 2 + (h)) * HTB)
#define PG8_SB(b, h) ((4 + (b) * 2 + (h)) * HTB)
#define PG8_STAGE(bufoff, gbase, voff) do { _Pragma("unroll") for (int _i = 0; _i < 2; ++_i) \
        __builtin_amdgcn_global_load_lds((const unsigned*)((const char*)(gbase) + (voff)[_i]), (PG8_LAS unsigned*)(lds + (bufoff) + ldsw + _i * 8192), 16, 0, 0); } while (0)
#define PG8_LDA(dst, b, h) do { _Pragma("unroll") for (int m = 0; m < 4; ++m) _Pragma("unroll") for (int k = 0; k < 2; ++k) dst[m][k] = *(const PG8_LAS bf16x8*)(lds + PG8_SA(b, h) + aoff + m * 2048 + k * 1024); } while (0)
#define PG8_LDB(dst, b, h) do { _Pragma("unroll") for (int n = 0; n < 2; ++n) _Pragma("unroll") for (int k = 0; k < 2; ++k) dst[n][k] = *(const PG8_LAS bf16x8*)(lds + PG8_SB(b, h) + boff + n * 2048 + k * 1024); } while (0)
#define PG8_MMA(ai, bj, At, Bt) do { __builtin_amdgcn_s_setprio(1); _Pragma("unroll") for (int m = 0; m < 4; ++m) _Pragma("unroll") for (int n = 0; n < 2; ++n) _Pragma("unroll") for (int k = 0; k < 2; ++k) \
        acc[ai][bj][m][n] = __builtin_amdgcn_mfma_f32_16x16x32_bf16(Bt[n][k], At[m][k], acc[ai][bj][m][n], 0, 0, 0); __builtin_amdgcn_s_setprio(0); } while (0)
#define PG8_WAIT_V(n) asm volatile("s_waitcnt vmcnt(" #n ")" ::: "memory")
#define PG8_WAIT_L(n) asm volatile("s_waitcnt lgkmcnt(" #n ")" ::: "memory")
#define PG8_BAR __builtin_amdgcn_s_barrier()
#define PG8_SCHED __builtin_amdgcn_sched_barrier(0)
    Unit cur, nxt; int ui = 0;
    if (!S.next(0, cur)) return;
    f32x4 acc[2][2][4][2];
#pragma unroll
    for (int a = 0; a < 2; ++a)
#pragma unroll
        for (int b = 0; b < 2; ++b)
#pragma unroll
            for (int m = 0; m < 4; ++m)
#pragma unroll
                for (int n = 0; n < 2; ++n) acc[a][b][m][n] = (f32x4){0.f, 0.f, 0.f, 0.f};
    bf16x8 At[4][2], B0[2][2], B1[2][2];
    const char* cA = (const char*)g.A + (size_t)cur.pm * tstepA; const char* cB = (const char*)g.Bt + (size_t)cur.pn * tstepB;
    if constexpr (Epi::HAS_PRE) E.pre(lds, cur, ui, wid, lane);
    PG8_STAGE(PG8_SB(0, 0), cB, voffB); PG8_STAGE(PG8_SB(0, 1), cB + hstepB, voffB); PG8_STAGE(PG8_SA(0, 0), cA, voffA); PG8_STAGE(PG8_SA(0, 1), cA + hstepA, voffA);
    if (wr == 1) PG8_BAR;
    PG8_WAIT_V(2); PG8_BAR;
    PG8_STAGE(PG8_SB(1, 0), cB + kstep, voffB); PG8_STAGE(PG8_SA(1, 0), cA + kstep, voffA); PG8_STAGE(PG8_SB(1, 1), cB + hstepB + kstep, voffB);
    PG8_WAIT_V(6); PG8_BAR;
    for (;;) {
        const bool has_next = S.next(ui + 1, nxt);
        const char* nA = has_next ? (const char*)g.A + (size_t)nxt.pm * tstepA : cA; const char* nB = has_next ? (const char*)g.Bt + (size_t)nxt.pn * tstepB : cB;
        for (int t = 0; t < nt; t += 2) {
            const bool last = (t == nt - 2);
            const char* a1 = cA + (size_t)(t + 1) * kstep;
            const char* a2 = last ? nA : cA + (size_t)(t + 2) * kstep; const char* b2 = last ? nB : cB + (size_t)(t + 2) * kstep;
            const char* a3 = a2 + kstep; const char* b3 = b2 + kstep;
            PG8_LDB(B0, 0, 0); PG8_LDB(B1, 0, 1); PG8_SCHED; PG8_LDA(At, 0, 0); PG8_STAGE(PG8_SA(1, 1), a1 + hstepA, voffA);
            PG8_WAIT_V(8); PG8_WAIT_L(0); PG8_BAR; PG8_MMA(0, 0, At, B0); PG8_MMA(0, 1, At, B1); PG8_BAR; PG8_SCHED;
            PG8_LDA(At, 0, 1); PG8_STAGE(PG8_SB(0, 0), b2, voffB); PG8_STAGE(PG8_SB(0, 1), b2 + hstepB, voffB); PG8_STAGE(PG8_SA(0, 0), a2, voffA);
            PG8_WAIT_V(8); PG8_WAIT_L(0); PG8_BAR; PG8_MMA(1, 0, At, B0); PG8_MMA(1, 1, At, B1); PG8_BAR; PG8_SCHED;
            PG8_LDB(B0, 1, 0); PG8_LDB(B1, 1, 1); PG8_SCHED; PG8_LDA(At, 1, 0); PG8_STAGE(PG8_SA(0, 1), a2 + hstepA, voffA);
            PG8_WAIT_V(8); PG8_WAIT_L(0); PG8_BAR; PG8_MMA(0, 0, At, B0); PG8_MMA(0, 1, At, B1); PG8_BAR; PG8_SCHED;
            PG8_LDA(At, 1, 1); PG8_STAGE(PG8_SB(1, 0), b3, voffB); PG8_STAGE(PG8_SB(1, 1), b3 + hstepB, voffB); PG8_STAGE(PG8_SA(1, 0), a3, voffA);
            PG8_WAIT_V(8); PG8_WAIT_L(0); PG8_BAR; PG8_MMA(1, 0, At, B0); PG8_MMA(1, 1, At, B1); PG8_BAR; PG8_SCHED;
        }
        if constexpr (ALIGN_EPI) { if (wr == 0) PG8_BAR; }
        if constexpr (Epi::HAS_PRE) E.run(acc, cur, ui, lds, wr, wc, fr, fq); else E(acc, cur, wr, wc, fr, fq);
        if (!has_next) break;
#pragma unroll
        for (int a = 0; a < 2; ++a)
#pragma unroll
            for (int b = 0; b < 2; ++b)
#pragma unroll
                for (int m = 0; m < 4; ++m)
#pragma unroll
                    for (int n = 0; n < 2; ++n) acc[a][b][m][n] = (f32x4){0.f, 0.f, 0.f, 0.f};
        cur = nxt; cA = nA; cB = nB; ++ui;
        if constexpr (Epi::HAS_PRE) E.pre(lds, cur, ui, wid, lane);
        if constexpr (ALIGN_EPI) { if (wr == 1) PG8_BAR; }
    }
    PG8_WAIT_V(0);
    if constexpr (!ALIGN_EPI) { if (wr == 0) PG8_BAR; }
    PG8_BAR;
#undef PG8_SA
#undef PG8_SB
#undef PG8_STAGE
#undef PG8_LDA
#undef PG8_LDB
#undef PG8_MMA
#undef PG8_WAIT_V
#undef PG8_WAIT_L
#undef PG8_BAR
#undef PG8_SCHED
}
}

__device__ __forceinline__ unsigned cvt_pk_bf16(float lo, float hi) { unsigned r; asm volatile("v_cvt_pk_bf16_f32 %0, %1, %2" : "=v"(r) : "v"(lo), "v"(hi)); return r; }
constexpr int SPARE_RS = 131072 + 1024, SPARE_CW = SPARE_RS + 2048, SPARE_ST = SPARE_CW + 4096, ST_ROW = 144, ST_WAVE = 16 * ST_ROW;
static_assert(SPARE_ST + 8 * ST_WAVE <= 163840, "LDS map");
__device__ __forceinline__ void st_rows_to_lane16(PG8_LAS unsigned char* wb, u32x4 r0, u32x4 r1, int fr, int fq, int rt, int ct, u32x4& p0, u32x4& p1) {
    *(PG8_LAS u32x4*)(wb + rt * ST_ROW + ct * 16) = r0; *(PG8_LAS u32x4*)(wb + (rt + 8) * ST_ROW + ct * 16) = r1;
    p0 = *(const PG8_LAS u32x4*)(wb + fr * ST_ROW + fq * 16); p1 = *(const PG8_LAS u32x4*)(wb + fr * ST_ROW + 64 + fq * 16);
}
__device__ __forceinline__ void st_lane16_to_rows(PG8_LAS unsigned char* wb, u32x4 p0, u32x4 p1, int fr, int fq, int rt, int ct, u32x4& r0, u32x4& r1) {
    *(PG8_LAS u32x4*)(wb + fr * ST_ROW + fq * 16) = p0; *(PG8_LAS u32x4*)(wb + fr * ST_ROW + 64 + fq * 16) = p1;
    r0 = *(const PG8_LAS u32x4*)(wb + rt * ST_ROW + ct * 16); r1 = *(const PG8_LAS u32x4*)(wb + (rt + 8) * ST_ROW + ct * 16);
}
__device__ __forceinline__ void st_rows_to_lane32(PG8_LAS unsigned char* wb, u32x4 r0, u32x4 r1, int fr, int fq, int rt, int ct, u32x4& p0, u32x4& p1) {
    *(PG8_LAS u32x4*)(wb + rt * ST_ROW + ct * 16) = r0; *(PG8_LAS u32x4*)(wb + (rt + 8) * ST_ROW + ct * 16) = r1;
    p0 = *(const PG8_LAS u32x4*)(wb + fr * ST_ROW + fq * 32); p1 = *(const PG8_LAS u32x4*)(wb + fr * ST_ROW + fq * 32 + 16);
}

struct EpiInProj {
    static constexpr bool PERM = true, ASIG = false, HAS_PRE = true; static constexpr int BMODE = 1;
    __device__ __forceinline__ void pre(PG8_LAS unsigned char*, const pg8::Unit&, int, int, int) const {}
    bf16_t* base; const float* qg; const float* kg; float* KM;
    __device__ __forceinline__ void run(const f32x4 (&acc)[2][2][4][2], const pg8::Unit& u, int ui, PG8_LAS unsigned char* lds, int wr, int wc, int fr, int fq) const {
        const int lane = fr + 16 * fq, rt = lane >> 3, ct = lane & 7; PG8_LAS unsigned char* wb = lds + SPARE_ST + (wr * 4 + wc) * ST_WAVE;
        const int gc0 = u.pn * 256, seg = gc0 >> 9;
        bf16_t* O = base + (size_t)seg * ((size_t)SEQ * 512) + (gc0 & 511) + 64 * wc + ct * 8;
        const int row0 = u.pm * 256 + wr * 64 + rt;
        if (seg == 2 || seg == 3) {
            const float* gp = (seg == 2) ? qg : kg; const float sc = (seg == 2) ? C2 : 1.0f;
            f32x4 gv[2][2], cs[2][2];
#pragma unroll
            for (int bj = 0; bj < 2; ++bj)
#pragma unroll
                for (int n = 0; n < 2; ++n) { gv[bj][n] = *(const f32x4*)(gp + 32 * bj + 8 * fq + 4 * n) * sc; cs[bj][n] = (f32x4){0.f, 0.f, 0.f, 0.f}; }
#pragma unroll
            for (int ai = 0; ai < 2; ++ai)
#pragma unroll
                for (int m = 0; m < 4; ++m) {
                    float ss = 0.f;
#pragma unroll
                    for (int bj = 0; bj < 2; ++bj)
#pragma unroll
                        for (int n = 0; n < 2; ++n) { const f32x4 x = acc[ai][bj][m][n]; ss += (x[0] * x[0] + x[1] * x[1]) + (x[2] * x[2] + x[3] * x[3]); }
                    ss += __shfl_xor(ss, 16); ss += __shfl_xor(ss, 32);
                    const float rstd = rsqrtf(ss * (1.0f / 64.0f) + EPS);
                    bf16_t* rowp = O + (size_t)(row0 + ai * 128 + m * 16) * 512; u32x4 w[2];
#pragma unroll
                    for (int bj = 0; bj < 2; ++bj) { const f32x4 v0 = acc[ai][bj][m][0] * rstd * gv[bj][0], v1 = acc[ai][bj][m][1] * rstd * gv[bj][1];
                        cs[bj][0] += v0; cs[bj][1] += v1;
                        w[bj].x = cvt_pk_bf16(v0[0], v0[1]); w[bj].y = cvt_pk_bf16(v0[2], v0[3]); w[bj].z = cvt_pk_bf16(v1[0], v1[1]); w[bj].w = cvt_pk_bf16(v1[2], v1[3]); }
                    u32x4 r0, r1; st_lane16_to_rows(wb, w[0], w[1], fr, fq, rt, ct, r0, r1); *(u32x4*)rowp = r0; *(u32x4*)(rowp + 8 * 512) = r1;
                }
            if (seg == 3) {
                float* kmp = KM + ((size_t)((u.pm >> 4) * NH + (u.pn & 1) * 4 + wc) * 16 + (u.pm & 15)) * 64 + 8 * fq;
#pragma unroll
                for (int bj = 0; bj < 2; ++bj)
#pragma unroll
                    for (int n = 0; n < 2; ++n)
#pragma unroll
                        for (int e = 0; e < 4; ++e) { float s = cs[bj][n][e]; s += __shfl_xor(s, 1); s += __shfl_xor(s, 2); s += __shfl_xor(s, 4); s += __shfl_xor(s, 8);
                            if (fr == 0) atomicAdd(kmp + 32 * bj + 4 * n + e, s * (1.0f / 256.0f)); }
            }
        } else {
#pragma unroll
            for (int ai = 0; ai < 2; ++ai)
#pragma unroll
                for (int m = 0; m < 4; ++m) { bf16_t* rowp = O + (size_t)(row0 + ai * 128 + m * 16) * 512; u32x4 w[2];
#pragma unroll
                    for (int bj = 0; bj < 2; ++bj) { const f32x4 v0 = acc[ai][bj][m][0], v1 = acc[ai][bj][m][1];
                        w[bj].x = cvt_pk_bf16(v0[0], v0[1]); w[bj].y = cvt_pk_bf16(v0[2], v0[3]); w[bj].z = cvt_pk_bf16(v1[0], v1[1]); w[bj].w = cvt_pk_bf16(v1[2], v1[3]); }
                    u32x4 r0, r1; st_lane16_to_rows(wb, w[0], w[1], fr, fq, rt, ct, r0, r1); *(u32x4*)rowp = r0; *(u32x4*)(rowp + 8 * 512) = r1; }
        }
    }
};
#define NT_LD(p) __builtin_nontemporal_load((const u32x4*)(p))
#define NT_ST(p, v) __builtin_nontemporal_store((v), (u32x4*)(p))
struct EpiBf16Plain {
    static constexpr bool PERM = true, ASIG = false, HAS_PRE = true; static constexpr int BMODE = 1;
    bf16_t* O; long pad_;
    static constexpr int ldc = DM;
    __device__ __forceinline__ void pre(PG8_LAS unsigned char*, const pg8::Unit&, int, int, int) const {}
    __device__ __forceinline__ void run(const f32x4 (&acc)[2][2][4][2], const pg8::Unit& u, int ui, PG8_LAS unsigned char* lds, int wr, int wc, int fr, int fq) const {
        int lane; asm volatile("v_mbcnt_lo_u32_b32 %0, -1, 0\n\tv_mbcnt_hi_u32_b32 %0, -1, %0" : "=&v"(lane));
        const int rt = lane >> 3, ct = lane & 7; PG8_LAS unsigned char* wb = lds + SPARE_ST + (wr * 4 + wc) * ST_WAVE;
        const int ob = (u.pm * 256 + wr * 64 + rt) * ldc + u.pn * 256 + 64 * wc + ct * 8;
#pragma unroll
        for (int ai = 0; ai < 2; ++ai)
#pragma unroll
            for (int m = 0; m < 4; ++m) { u32x4 w[2];
#pragma unroll
                for (int bj = 0; bj < 2; ++bj) { const f32x4 v0 = acc[ai][bj][m][0], v1 = acc[ai][bj][m][1];
                    w[bj].x = cvt_pk_bf16(v0[0], v0[1]); w[bj].y = cvt_pk_bf16(v0[2], v0[3]); w[bj].z = cvt_pk_bf16(v1[0], v1[1]); w[bj].w = cvt_pk_bf16(v1[2], v1[3]); }
                u32x4 r0, r1; st_lane16_to_rows(wb, w[0], w[1], fr, fq, rt, ct, r0, r1);
                bf16_t* rowp = O + (ob + (ai * 128 + m * 16) * ldc); NT_ST(rowp, r0); NT_ST(rowp + 8 * ldc, r1); }
    }
};
template <int BASE> struct EpiResid {
    static constexpr bool PERM = true, ASIG = false, HAS_PRE = true, BASE_BF16 = (BASE != 0); static constexpr int BMODE = 1;
    const void* basev; bf16_t* xb; float* ss; const float* rinv; const float* gmix;
    __device__ __forceinline__ void pre(PG8_LAS unsigned char*, const pg8::Unit&, int, int, int) const {}
    __device__ __forceinline__ void run(const f32x4 (&acc)[2][2][4][2], const pg8::Unit& u, int ui, PG8_LAS unsigned char* lds, int wr, int wc, int fr, int fq) const {
        const int lane = fr + 16 * fq, rt = lane >> 3, ct = lane & 7;
        PG8_LAS unsigned char* wb = lds + SPARE_ST + (wr * 4 + wc) * ST_WAVE;
        const int rows0 = u.pm * 256 + wr * 64, cols0 = u.pn * 256 + 64 * wc;
        constexpr int DEPTH = BASE_BF16 ? 4 : 2, NR = BASE_BF16 ? 2 : 4;
        u32x4 X[DEPTH][NR];
#define ER_LOAD(slot, g) do { const size_t r_ = (size_t)(rows0 + ((g) >> 2) * 128 + ((g) & 3) * 16 + rt) * DM + cols0; \
        if constexpr (BASE_BF16) { X[slot][0] = NT_LD((const bf16_t*)basev + r_ + ct * 8); X[slot][1] = NT_LD((const bf16_t*)basev + r_ + 8 * DM + ct * 8); } \
        else { X[slot][0] = NT_LD((const float*)basev + r_ + ct * 4); X[slot][1] = NT_LD((const float*)basev + r_ + 8 * DM + ct * 4); \
               X[slot][2] = NT_LD((const float*)basev + r_ + 32 + ct * 4); X[slot][3] = NT_LD((const float*)basev + r_ + 8 * DM + 32 + ct * 4); } } while (0)
#pragma unroll
        for (int g = 0; g < DEPTH; ++g) ER_LOAD(g, g);
        float ri[8]; f32x4 gi[2][2];
        if constexpr (BASE == 2) {
#pragma unroll
            for (int g = 0; g < 8; ++g) ri[g] = rinv[rows0 + (g >> 2) * 128 + (g & 3) * 16 + fr];
#pragma unroll
            for (int bj = 0; bj < 2; ++bj)
#pragma unroll
                for (int n = 0; n < 2; ++n) { const f32x4 gg = *(const f32x4*)(gmix + cols0 + 32 * bj + 8 * fq + 4 * n);
                    gi[bj][n] = (f32x4){__builtin_amdgcn_rcpf(gg[0]), __builtin_amdgcn_rcpf(gg[1]), __builtin_amdgcn_rcpf(gg[2]), __builtin_amdgcn_rcpf(gg[3])}; } }
#pragma unroll
        for (int g = 0; g < 8; ++g) { const int ai = g >> 2, m = g & 3; float s = 0.f;
            f32x4 bs[2][2];
            if constexpr (BASE_BF16) { u32x4 p0, p1; st_rows_to_lane16(wb, X[g % DEPTH][0], X[g % DEPTH][1], fr, fq, rt, ct, p0, p1);
                bs[0][0] = (f32x4){bf2f(p0.x & 0xffffu), bf2f(p0.x >> 16), bf2f(p0.y & 0xffffu), bf2f(p0.y >> 16)}; bs[0][1] = (f32x4){bf2f(p0.z & 0xffffu), bf2f(p0.z >> 16), bf2f(p0.w & 0xffffu), bf2f(p0.w >> 16)};
                bs[1][0] = (f32x4){bf2f(p1.x & 0xffffu), bf2f(p1.x >> 16), bf2f(p1.y & 0xffffu), bf2f(p1.y >> 16)}; bs[1][1] = (f32x4){bf2f(p1.z & 0xffffu), bf2f(p1.z >> 16), bf2f(p1.w & 0xffffu), bf2f(p1.w >> 16)}; }
            else {
#pragma unroll
                for (int bj = 0; bj < 2; ++bj) { u32x4 p0, p1; st_rows_to_lane32(wb, X[g % DEPTH][2 * bj], X[g % DEPTH][2 * bj + 1], fr, fq, rt, ct, p0, p1);
                    bs[bj][0] = __builtin_bit_cast(f32x4, p0); bs[bj][1] = __builtin_bit_cast(f32x4, p1); } }
            if (g + DEPTH < 8) ER_LOAD(g % DEPTH, g + DEPTH);
            if constexpr (BASE == 2) {
#pragma unroll
                for (int bj = 0; bj < 2; ++bj)
#pragma unroll
                    for (int n = 0; n < 2; ++n) bs[bj][n] = bs[bj][n] * gi[bj][n] * ri[g]; }
            u32x4 pc[2];
#pragma unroll
            for (int bj = 0; bj < 2; ++bj) { const f32x4 o0 = bs[bj][0] + acc[ai][bj][m][0], o1 = bs[bj][1] + acc[ai][bj][m][1];
                s += ((o0[0] * o0[0] + o0[1] * o0[1]) + (o0[2] * o0[2] + o0[3] * o0[3])) + ((o1[0] * o1[0] + o1[1] * o1[1]) + (o1[2] * o1[2] + o1[3] * o1[3]));
                pc[bj].x = cvt_pk_bf16(o0[0], o0[1]); pc[bj].y = cvt_pk_bf16(o0[2], o0[3]); pc[bj].z = cvt_pk_bf16(o1[0], o1[1]); pc[bj].w = cvt_pk_bf16(o1[2], o1[3]); }
            u32x4 r0, r1; st_lane16_to_rows(wb, pc[0], pc[1], fr, fq, rt, ct, r0, r1);
            bf16_t* op = xb + (size_t)(rows0 + ai * 128 + m * 16 + rt) * DM + cols0 + ct * 8;
            *(u32x4*)op = r0; *(u32x4*)(op + 8 * DM) = r1;
            s += __shfl_xor(s, 16); s += __shfl_xor(s, 32);
            if (fq == 0) ss[(size_t)(rows0 + ai * 128 + m * 16 + fr) * 16 + u.pn * 4 + wc] = s; }
#undef ER_LOAD
    }
};
__device__ __forceinline__ f32x4 ss_part(const float* ss, int row, int fq) { return *(const f32x4*)(ss + (size_t)row * 16 + 4 * fq); }
__device__ __forceinline__ float rstd_from(f32x4 p) { float s = (p[0] + p[1]) + (p[2] + p[3]); s += __shfl_xor(s, 16); s += __shfl_xor(s, 32); return rsqrtf(s * (1.0f / DM) + EPS); }
__device__ __forceinline__ float row_rstd(const float* ss, int row, int fq) {
    const f32x4 p = *(const f32x4*)(ss + (size_t)row * 16 + 4 * fq); float s = (p[0] + p[1]) + (p[2] + p[3]);
    s += __shfl_xor(s, 16); s += __shfl_xor(s, 32); return rsqrtf(s * (1.0f / DM) + EPS);
}
__device__ __forceinline__ float dpp_shr1(float old, float v) { return __builtin_bit_cast(float, __builtin_amdgcn_update_dpp(__builtin_bit_cast(int, old), __builtin_bit_cast(int, v), 0x111, 0xf, 0xf, false)); }
__device__ __forceinline__ float dpp_ror1(float v) { return __builtin_bit_cast(float, __builtin_amdgcn_update_dpp(__builtin_bit_cast(int, v), __builtin_bit_cast(int, v), 0x121, 0xf, 0xf, false)); }
struct EpiUpFused {
    static constexpr bool PERM = true, ASIG = true, HAS_PRE = true; static constexpr int BMODE = 2;
    bf16_t* ACT; const float* cw; const float* cb; float* GT; float* PART; float* VH; const float* ssg; int pm0, pm1;
    __device__ __forceinline__ void pre(PG8_LAS unsigned char* lds, const pg8::Unit& u, int ui, int wid, int lane) const {
        if (wid < 2) { const int idx = 4 * (64 * wid + lane), arr = idx >> 7, col = idx & 127; const float* src_ = (arr < 3 ? cw + (size_t)arr * DFF : cb) + u.pn * 128 + col;
            __builtin_amdgcn_global_load_lds((const unsigned*)src_, (PG8_LAS unsigned*)(lds + SPARE_CW + (ui & 1) * 2048 + wid * 1024), 16, 0, 0); }
    }
    __device__ __forceinline__ void run(const f32x4 (&acc)[2][2][4][2], const pg8::Unit& u, int ui, PG8_LAS unsigned char* lds, int wr, int wc, int fr, int fq) const {
        const int j0 = u.pn * 128 + wc * 32 + 8 * fq, rbase = u.pm * 256 + 128 * wr + 8 * fr, strip = u.pm * 2 + wr;
        float rs[8];
        if (pm1 >= 0) { const PG8_LAS f32x4* rp = (const PG8_LAS f32x4*)(lds + SPARE_RS + (u.pm == pm0 ? 0 : 1024) + (128 * wr + 8 * fr) * 4); const f32x4 r0 = rp[0], r1 = rp[1];
          rs[0] = r0[0]; rs[1] = r0[1]; rs[2] = r0[2]; rs[3] = r0[3]; rs[4] = r1[0]; rs[5] = r1[1]; rs[6] = r1[2]; rs[7] = r1[3]; }
        else {
#pragma unroll
            for (int s = 0; s < 8; ++s) rs[s] = rstd_from(ss_part(ssg, rbase + s, fq)); }
        f32x2 w0[4], w1[4], w2[4], bb[4], pm1[4], pm2[4];
        { const PG8_LAS f32x4* wp = (const PG8_LAS f32x4*)(lds + SPARE_CW + (ui & 1) * 2048 + (wc * 32 + 8 * fq) * 4);
          const f32x4 a0 = wp[0], a1 = wp[1], b0 = wp[32], b1 = wp[33], c0 = wp[64], c1 = wp[65], d0 = wp[96], d1 = wp[97];
          w0[0] = (f32x2){a0[0], a0[1]}; w0[1] = (f32x2){a0[2], a0[3]}; w0[2] = (f32x2){a1[0], a1[1]}; w0[3] = (f32x2){a1[2], a1[3]};
          w1[0] = (f32x2){b0[0], b0[1]}; w1[1] = (f32x2){b0[2], b0[3]}; w1[2] = (f32x2){b1[0], b1[1]}; w1[3] = (f32x2){b1[2], b1[3]};
          w2[0] = (f32x2){c0[0], c0[1]}; w2[1] = (f32x2){c0[2], c0[3]}; w2[2] = (f32x2){c1[0], c1[1]}; w2[3] = (f32x2){c1[2], c1[3]};
          bb[0] = (f32x2){d0[0], d0[1]}; bb[1] = (f32x2){d0[2], d0[3]}; bb[2] = (f32x2){d1[0], d1[1]}; bb[3] = (f32x2){d1[2], d1[3]}; }
#pragma unroll
        for (int q = 0; q < 4; ++q) { const int n = q >> 1, h = q & 1;
            const f32x2 g6 = (f32x2){acc[1][0][2][n][2 * h], acc[1][0][2][n][2 * h + 1]} * rs[6], g7 = (f32x2){acc[1][0][3][n][2 * h], acc[1][0][3][n][2 * h + 1]} * rs[7];
            pm2[q].x = dpp_shr1(0.f, g6.x); pm2[q].y = dpp_shr1(0.f, g6.y); pm1[q].x = dpp_shr1(0.f, g7.x); pm1[q].y = dpp_shr1(0.f, g7.y); }
#pragma unroll
        for (int s = 0; s < 8; ++s) { const int ai = s >> 2, m = s & 3, row = rbase + s; const float rstd = rs[s];
            f32x2 a[4];
#pragma unroll
            for (int q = 0; q < 4; ++q) { const int n = q >> 1, h = q & 1;
                const f32x2 g = (f32x2){acc[ai][0][m][n][2 * h], acc[ai][0][m][n][2 * h + 1]} * rstd, v = (f32x2){acc[ai][1][m][n][2 * h], acc[ai][1][m][n][2 * h + 1]} * rstd;
                const f32x2 pre = w0[q] * pm2[q] + (w1[q] * pm1[q] + (w2[q] * g + bb[q]));
                pm2[q] = pm1[q]; pm1[q] = g;
                const f32x2 t = pre * pre, uu = t * (-0.0713548163f * LOG2E) + (-1.5957691216f * LOG2E), z = pre * uu;
                f32x2 ee; ee.x = __builtin_amdgcn_exp2f(z.x); ee.y = __builtin_amdgcn_exp2f(z.y);
                const f32x2 dd = ee + 1.0f; f32x2 rr; rr.x = __builtin_amdgcn_rcpf(dd.x); rr.y = __builtin_amdgcn_rcpf(dd.y);
                a[q] = (pre * rr) * v;
                if (s < 2 && fr == 0) { *(f32x2*)(PART + ((size_t)strip * 2 + s) * DFF + j0 + 2 * q) = pre; *(f32x2*)(VH + ((size_t)strip * 2 + s) * DFF + j0 + 2 * q) = v; }
                if (s >= 6 && fr == 15) *(f32x2*)(GT + ((size_t)strip * 2 + (s - 6)) * DFF + j0 + 2 * q) = g; }
            u32x4 w; w.x = cvt_pk_bf16(a[0].x, a[0].y); w.y = cvt_pk_bf16(a[1].x, a[1].y); w.z = cvt_pk_bf16(a[2].x, a[2].y); w.w = cvt_pk_bf16(a[3].x, a[3].y);
            *(u32x4*)(ACT + (size_t)row * DFF + j0) = w; }
    }
};
struct EpiFinal {
    static constexpr bool PERM = true, ASIG = false, HAS_PRE = true; static constexpr int BMODE = 1;
    float* out; const bf16_t* h2b; const bf16_t* prj; const float* ss;
    __device__ __forceinline__ void pre(PG8_LAS unsigned char*, const pg8::Unit&, int, int, int) const {}
    __device__ __forceinline__ void run(const f32x4 (&acc)[2][2][4][2], const pg8::Unit& u, int ui, PG8_LAS unsigned char* lds, int wr, int wc, int fr, int fq) const {
        const int lane = fr + 16 * fq, rt = lane >> 3, ct = lane & 7;
        PG8_LAS unsigned char* wb = lds + SPARE_ST + (wr * 4 + wc) * ST_WAVE;
        const int rows0 = u.pm * 256 + wr * 64, cols0 = u.pn * 256 + 64 * wc;
        float rs[8];
        { f32x4 sp[8];
#pragma unroll
          for (int g = 0; g < 8; ++g) sp[g] = ss_part(ss, rows0 + (g >> 2) * 128 + (g & 3) * 16 + fr, fq);
#pragma unroll
          for (int g = 0; g < 8; ++g) rs[g] = rstd_from(sp[g]); }
        constexpr int DEPTH = 3;
        u32x4 H[DEPTH][2], P[DEPTH][2];
#define EF_LOAD(slot, g) do { const size_t o_ = (size_t)(rows0 + ((g) >> 2) * 128 + ((g) & 3) * 16 + rt) * DM + cols0 + ct * 8; \
        H[slot][0] = NT_LD(h2b + o_); H[slot][1] = NT_LD(h2b + o_ + 8 * DM); P[slot][0] = NT_LD(prj + o_); P[slot][1] = NT_LD(prj + o_ + 8 * DM); } while (0)
#pragma unroll
        for (int g = 0; g < DEPTH; ++g) EF_LOAD(g, g);
#pragma unroll
        for (int g = 0; g < 8; ++g) { const int ai = g >> 2, m = g & 3; const float rstd = rs[g];
            u32x4 hv[2], pv[2];
            *(PG8_LAS u32x4*)(wb + rt * ST_ROW + ct * 16) = H[g % DEPTH][0]; *(PG8_LAS u32x4*)(wb + (rt + 8) * ST_ROW + ct * 16) = H[g % DEPTH][1];
            hv[0] = *(const PG8_LAS u32x4*)(wb + fr * ST_ROW + fq * 16); hv[1] = *(const PG8_LAS u32x4*)(wb + fr * ST_ROW + 64 + fq * 16);
            *(PG8_LAS u32x4*)(wb + rt * ST_ROW + ct * 16) = P[g % DEPTH][0]; *(PG8_LAS u32x4*)(wb + (rt + 8) * ST_ROW + ct * 16) = P[g % DEPTH][1];
            pv[0] = *(const PG8_LAS u32x4*)(wb + fr * ST_ROW + fq * 16); pv[1] = *(const PG8_LAS u32x4*)(wb + fr * ST_ROW + 64 + fq * 16);
            if (g + DEPTH < 8) EF_LOAD(g % DEPTH, g + DEPTH);
#pragma unroll
            for (int bj = 0; bj < 2; ++bj) { f32x4 o[2];
#pragma unroll
                for (int n = 0; n < 2; ++n) { const f32x4 a = acc[ai][bj][m][n] * rstd; const unsigned h0 = hv[bj][2 * n], h1 = hv[bj][2 * n + 1], p0 = pv[bj][2 * n], p1 = pv[bj][2 * n + 1];
                    o[n][0] = bf2f(h0 & 0xffffu) + sigmoidf_(a[0]) * bf2f(p0 & 0xffffu); o[n][1] = bf2f(h0 >> 16) + sigmoidf_(a[1]) * bf2f(p0 >> 16);
                    o[n][2] = bf2f(h1 & 0xffffu) + sigmoidf_(a[2]) * bf2f(p1 & 0xffffu); o[n][3] = bf2f(h1 >> 16) + sigmoidf_(a[3]) * bf2f(p1 >> 16); }
                *(PG8_LAS u32x4*)(wb + fr * ST_ROW + fq * 32) = __builtin_bit_cast(u32x4, o[0]); *(PG8_LAS u32x4*)(wb + fr * ST_ROW + fq * 32 + 16) = __builtin_bit_cast(u32x4, o[1]);
                const u32x4 r0 = *(const PG8_LAS u32x4*)(wb + rt * ST_ROW + ct * 16), r1 = *(const PG8_LAS u32x4*)(wb + (rt + 8) * ST_ROW + ct * 16);
                float* op = out + (size_t)(rows0 + ai * 128 + m * 16 + rt) * DM + cols0 + 32 * bj + ct * 4;
                NT_ST(op, r0); NT_ST(op + 8 * DM, r1); } }
#undef EF_LOAD
    }
};

#define GAS __attribute__((address_space(1)))
#define LAS __attribute__((address_space(3)))
typedef float f32x16 __attribute__((ext_vector_type(16)));
#define LDS_WAIT() asm volatile("s_waitcnt lgkmcnt(0)" ::: "memory")
#define VM_WAIT() asm volatile("s_waitcnt vmcnt(0)" ::: "memory")
constexpr int NWAVES = 8;
constexpr int RING_BYTES = 131072, MISC_OFF = RING_BYTES + 320, LDS_BYTES = 163840;

#define XB_TMO      128
#define XB_XCNT(j)  (256  + 64 * (j))
#define XB_XSUB(j)  (1280 + 64 * (j))
#define XB_XGEN(j)  (2304 + 64 * (j))
#define XB_TOP      3328
#define XB_TOPGEN   3392
#define XCD_BAR_WORDS 3456
#define XB_SPIN_CAP (1u << 20)
__device__ __forceinline__ unsigned xb_ld(unsigned* p)              { return __hip_atomic_load(p, __ATOMIC_RELAXED, __HIP_MEMORY_SCOPE_AGENT); }
__device__ __forceinline__ unsigned xb_add(unsigned* p, unsigned v) { return __hip_atomic_fetch_add(p, v, __ATOMIC_RELAXED, __HIP_MEMORY_SCOPE_AGENT); }
__device__ __forceinline__ unsigned xb_xcc_id() { return (unsigned)__builtin_amdgcn_s_getreg((3 << 11) | 20) & 0xFu; }
#define XB_SPIN(cond, bar) do { unsigned _sp = 0; while (cond) { __builtin_amdgcn_s_sleep(1); \
    if ((++_sp & 255u) == 0u) { if (xb_ld(&(bar)[XB_TMO])) break; if (_sp > XB_SPIN_CAP) { atomicAdd(&(bar)[XB_TMO], 1u); break; } } } } while (0)
struct XcdBarrier { unsigned* bar; unsigned x; volatile LAS unsigned* st; };
__device__ __forceinline__ XcdBarrier xcd_barrier_post(unsigned* bar, volatile LAS unsigned* st) {
    XcdBarrier b; b.bar = bar; b.x = xb_xcc_id(); b.st = st;
    if (threadIdx.x == 0) { (void)xb_add(&bar[XB_XCNT(b.x)], 1u); __hip_atomic_store(&bar[10240   + blockIdx.x], b.x + 1u, __ATOMIC_RELAXED, __HIP_MEMORY_SCOPE_AGENT); }
    return b;
}
__device__ __forceinline__ void xcd_barrier_complete(unsigned* bar, unsigned x, unsigned& nloc, unsigned& nx) {
    const unsigned G = gridDim.x * gridDim.y * gridDim.z;
    unsigned sum, cnt, mine, sp = 0u;
    for (;;) {
        sum = 0u; cnt = 0u; mine = 0u;
#pragma unroll
        for (unsigned j = 0; j < 16; ++j) { const unsigned c = xb_ld(&bar[XB_XCNT(j)]); sum += c; cnt += (c > 0u) ? 1u : 0u; mine = (j == x) ? c : mine; }
        if (sum == G) break;
        __builtin_amdgcn_s_sleep(1);
        if ((++sp & 255u) == 0u) { if (xb_ld(&bar[XB_TMO])) break; if (sp > XB_SPIN_CAP) { atomicAdd(&bar[XB_TMO], 1u); break; } }
    }
    nloc = mine > 0u ? mine : 1u; nx = cnt > 0u ? cnt : 1u;
}
__device__ __forceinline__ void xcd_barrier(const XcdBarrier& b) {
    asm volatile("s_waitcnt vmcnt(0)" ::: "memory");
    __syncthreads();
    if (threadIdx.x == 0) {
        unsigned* bar = b.bar;
        __builtin_amdgcn_s_waitcnt(0);
        unsigned nloc = b.st[0], nx = b.st[1];
        if (nloc == 0u) { xcd_barrier_complete(bar, b.x, nloc, nx); b.st[0] = nloc; b.st[1] = nx; }
        const unsigned old = xb_add(&bar[XB_XSUB(b.x)], 1u);
        const unsigned gen = old / nloc;
        if (old + 1u == (gen + 1u) * nloc) {
            __builtin_amdgcn_fence(__ATOMIC_RELEASE, "agent");
            asm volatile("s_waitcnt vmcnt(0)" ::: "memory");
            const unsigned og = xb_add(&bar[XB_TOP], 1u);
            const unsigned tg = og / nx;
            if (og + 1u == (tg + 1u) * nx) xb_add(&bar[XB_TOPGEN], 1u);
            else XB_SPIN(xb_ld(&bar[XB_TOPGEN]) == tg, bar);
            __builtin_amdgcn_fence(__ATOMIC_ACQUIRE, "agent");
            xb_add(&bar[XB_XGEN(b.x)], 1u);
            asm volatile("s_waitcnt vmcnt(0)" ::: "memory");
        } else {
            XB_SPIN(xb_ld(&bar[XB_XGEN(b.x)]) == gen, bar);
            __builtin_amdgcn_fence(__ATOMIC_ACQUIRE, "agent");
            asm volatile("s_waitcnt vmcnt(0)" ::: "memory");
        }
    }
    __syncthreads();
}

#define GB_SUB(r) (9216 + 64 * (r))
#define GB_GEN(r) (9728 + 64 * (r))
#define GB_XID    10240
#define GB_WCNT   10752
struct GrpBarV { unsigned* bar; unsigned r, n, fast; };
__device__ __forceinline__ void grp_barrier(unsigned* bar_, volatile LAS unsigned* fastp) {
    asm volatile("s_waitcnt vmcnt(0)" ::: "memory");
    __syncthreads();
    if (threadIdx.x == 0) {
        GrpBarV g{bar_, blockIdx.x & 7u, gridDim.x >> 3, *fastp};
        unsigned* bar = g.bar;
        if (g.fast == 0u) {
            const unsigned me = xb_ld(&bar[GB_XID + blockIdx.x]); bool ok = (me != 0u);
            for (unsigned i = g.r; i < gridDim.x; i += 8u) ok = ok && (xb_ld(&bar[GB_XID + i]) == me);
            g.fast = ok ? 1u : 2u; *fastp = g.fast; }
        if (g.fast != 1u) { __builtin_amdgcn_fence(__ATOMIC_RELEASE, "agent"); asm volatile("s_waitcnt vmcnt(0)" ::: "memory"); }
        const unsigned old = xb_add(&bar[GB_SUB(g.r)], 1u);
        const unsigned gen = old / g.n;
        if (old + 1u == (gen + 1u) * g.n) __hip_atomic_store(&bar[GB_GEN(g.r)], gen + 1u, __ATOMIC_RELAXED, __HIP_MEMORY_SCOPE_AGENT);
        else XB_SPIN(xb_ld(&bar[GB_GEN(g.r)]) <= gen, bar);
        __builtin_amdgcn_fence(__ATOMIC_ACQUIRE, "agent");
        asm volatile("s_waitcnt vmcnt(0)" ::: "memory");
    }
    __syncthreads();
}

constexpr size_t MiB = 1u << 20;
constexpr size_t WS_CTL = 0, CTL_ZERO_BYTES = 64 * 1024;
constexpr size_t WS_RINV0 = 6 * MiB + 512 * 1024;
constexpr size_t WS_KM = 1 * MiB, WS_SS1 = 2 * MiB, WS_SS2 = 4 * MiB, WS_GW = 6 * MiB  , WS_SUMM = 7 * MiB  ;
constexpr size_t WS_WIN = 8 * MiB, WS_WOUT = 13 * MiB, WS_WUP = 15 * MiB, WS_WDN = 27 * MiB, WS_WG = 33 * MiB, WS_WP = 35 * MiB;
constexpr size_t WS_XN = 40 * MiB;
constexpr size_t WS_PB = 104 * MiB;
constexpr size_t WS_PRJ = 120 * MiB;
constexpr size_t WS_R = 184 * MiB, SLAB = 32 * MiB;
constexpr size_t WS_GT = 480 * MiB, WS_PART = 488 * MiB, WS_VH = 496 * MiB;
constexpr size_t WS_END = 512 * MiB;

struct Args { const float* in[22]; float* out; unsigned char* ws; int ph_lo, ph_hi; };
struct Frame {
    LAS unsigned char* lds; int tid, lane, wave, vcu, G;
};
__device__ __forceinline__ float wave_sum(float v) {
#pragma unroll
    for (int o = 1; o < 64; o <<= 1) v += __shfl_xor(v, o);
    return v;
}
__device__ __forceinline__ float wave_max(float v) {
#pragma unroll
    for (int o = 1; o < 64; o <<= 1) v = fmaxf(v, __shfl_xor(v, o));
    return v;
}
__device__ __forceinline__ void p0_transpose_item(const float* W, int ldw, int N, bf16_t* WT, int ldt, const float* gain, LAS float* scr, int item, int lane) {
    const int nblk = N / 32, kb = item / nblk, nb = item % nblk, k0 = 64 * kb, n0 = 32 * nb;
#pragma unroll
    for (int i = 0; i < 32; ++i) { const int kk = 2 * i + (lane >> 5); scr[kk * 33 + (lane & 31)] = __builtin_nontemporal_load(W + (size_t)(k0 + kk) * ldw + n0 + (lane & 31)) * (gain ? gain[k0 + kk] : 1.0f); }
    LDS_WAIT(); asm volatile("" ::: "memory");
    const int c = lane & 7;
#pragma unroll
    for (int j = 0; j < 4; ++j) { const int n = (lane >> 3) + 8 * j; const LAS float* s = scr + (8 * c) * 33 + n;
        u32x4 o; o.x = pk2(s[0 * 33], s[1 * 33]); o.y = pk2(s[2 * 33], s[3 * 33]); o.z = pk2(s[4 * 33], s[5 * 33]); o.w = pk2(s[6 * 33], s[7 * 33]);
        asm volatile("global_store_dwordx4 %0, %1, off sc0 sc1" :: "v"(WT + (size_t)(n0 + n) * ldt + k0 + 8 * c), "v"(o) : "memory"); }
    LDS_WAIT(); asm volatile("" ::: "memory");
}
__device__ __forceinline__ int crow16(int r, int hi) { return (r & 3) + 8 * (r >> 2) + 4 * hi; }
struct LruP { const bf16_t* __restrict__ XL; const bf16_t* __restrict__ GL; const float* __restrict__ cw; const float* __restrict__ cb; const bf16_t* __restrict__ WaT; const bf16_t* __restrict__ WxT;
              const float* __restrict__ ba; const float* __restrict__ bx; const float* __restrict__ lam; f32x2* SUMM; bf16_t* __restrict__ Y; unsigned* __restrict__ LAB; };
__device__ __forceinline__ void lru_scan_groups(const float (&av)[16], const float (&bv)[16], int hi, float (&sA)[8], float (&sB)[8], float& Aw, float& Bw) {
    float Ag[4], Bg[4];
#pragma unroll
    for (int gq = 0; gq < 4; ++gq) { const float a0 = av[4 * gq], a1 = av[4 * gq + 1], a2 = av[4 * gq + 2], a3 = av[4 * gq + 3];
        const float b0 = bv[4 * gq], b1 = bv[4 * gq + 1], b2 = bv[4 * gq + 2], b3 = bv[4 * gq + 3];
        Ag[gq] = (a0 * a1) * (a2 * a3); Bg[gq] = ((b0 * a1 + b1) * a2 + b2) * a3 + b3; }
    Aw = 1.f; Bw = 0.f;
#pragma unroll
    for (int gq = 0; gq < 4; ++gq) { const float oA = __shfl_xor(Ag[gq], 32), oB = __shfl_xor(Bg[gq], 32);
        sA[2 * gq] = hi ? oA : Ag[gq]; sB[2 * gq] = hi ? oB : Bg[gq]; sA[2 * gq + 1] = hi ? Ag[gq] : oA; sB[2 * gq + 1] = hi ? Bg[gq] : oB; }
#pragma unroll
    for (int G = 0; G < 8; ++G) { Bw = sA[G] * Bw + sB[G]; Aw *= sA[G]; }
}
constexpr int LR_XT = 4096, LR_CARRY = LR_XT + 8 * 40 * 144, LR_WA = LR_CARRY + 256, LR_WX = LR_WA + 64 * 144, LR_CW = LR_WX + 64 * 144, LR_CB = LR_CW + 1024, LR_BA = LR_CB + 256, LR_BX = LR_BA + 256, LR_SP = LR_BX + 256;
__device__ __forceinline__ void lru_setup(const LruP& P, LAS unsigned char* lds, int n, int tid) {
    { const int d = tid >> 3, ch = tid & 7;
      *(LAS u32x4*)(lds + LR_WA + d * 144 + ch * 16) = *(const u32x4*)(P.WaT + ((size_t)(n * 64 + d)) * 64 + ch * 8);
      *(LAS u32x4*)(lds + LR_WX + d * 144 + ch * 16) = *(const u32x4*)(P.WxT + ((size_t)(n * 64 + d)) * 64 + ch * 8); }
    if (tid < 256) ((LAS float*)(lds + LR_CW))[tid] = P.cw[(tid >> 6) * LRU_W + n * 64 + (tid & 63)];
    if (tid < 64) { const int ch = n * 64 + tid; ((LAS float*)(lds + LR_CB))[tid] = P.cb[ch]; ((LAS float*)(lds + LR_BA))[tid] = P.ba[ch]; ((LAS float*)(lds + LR_BX))[tid] = P.bx[ch];
        ((LAS float*)(lds + LR_SP))[tid] = -8.0f * LOG2E * log1pf(__expf(-P.lam[ch])); }
    LDS_WAIT(); __syncthreads();
}
struct LruTile { u32x4 v[5]; };
__device__ __forceinline__ void lru_tile_load(const LruP& P, LruTile& T, int unit, int wave, int lane) {
    const int c = unit & 15, n = (unit >> 4) & 7, b = unit >> 7, t0 = c * 256 + wave * 32, rt = lane >> 3, ct = lane & 7;
#pragma unroll
    for (int p = 0; p < 5; ++p) { const int tr = t0 - 3 + 8 * p + rt; T.v[p] = (u32x4){0u, 0u, 0u, 0u};
        if (tr >= 0 && tr < SEQ) T.v[p] = NT_LD(P.XL + ((size_t)b * SEQ + tr) * 512 + n * 64 + ct * 8); }
}
__device__ __forceinline__ void lru_unit_fused(const LruP& P, LAS unsigned char* lds, unsigned* cnt, LruTile& T, int unit, int next_unit, int wave, int lane) {
    const int c = unit & 15, n = (unit >> 4) & 7, b = unit >> 7, r32 = lane & 31, hi = lane >> 5;
    const int t0 = c * 256 + wave * 32; const size_t m0 = (size_t)b * SEQ + t0;
    LAS unsigned char* xt = lds + LR_XT + wave * (40 * 144);
    { const int rt = lane >> 3, ct = lane & 7;
#pragma unroll
      for (int p = 0; p < 5; ++p) *(LAS u32x4*)(xt + (8 * p + rt) * 144 + ct * 16) = T.v[p]; }
    bf16x8 afr[4];
#pragma unroll
    for (int ks = 0; ks < 4; ++ks) { const int cl = 16 * ks + 8 * hi;
        f32x4 x0 = *(const LAS f32x4*)(lds + LR_CB + cl * 4), x1 = *(const LAS f32x4*)(lds + LR_CB + cl * 4 + 16);
#pragma unroll
        for (int k = 0; k < 4; ++k) { const u32x4 w = *(const LAS u32x4*)(xt + (r32 + k) * 144 + (2 * ks + hi) * 16);
            const f32x4 c0 = *(const LAS f32x4*)(lds + LR_CW + (k * 64 + cl) * 4), c1 = *(const LAS f32x4*)(lds + LR_CW + (k * 64 + cl) * 4 + 16);
            x0[0] += c0[0] * bf2f(w.x & 0xffffu); x0[1] += c0[1] * bf2f(w.x >> 16); x0[2] += c0[2] * bf2f(w.y & 0xffffu); x0[3] += c0[3] * bf2f(w.y >> 16);
            x1[0] += c1[0] * bf2f(w.z & 0xffffu); x1[1] += c1[1] * bf2f(w.z >> 16); x1[2] += c1[2] * bf2f(w.w & 0xffffu); x1[3] += c1[3] * bf2f(w.w >> 16); }
        u32x4 pw; pw.x = cvt_pk_bf16(x0[0], x0[1]); pw.y = cvt_pk_bf16(x0[2], x0[3]); pw.z = cvt_pk_bf16(x1[0], x1[1]); pw.w = cvt_pk_bf16(x1[2], x1[3]);
        afr[ks] = __builtin_bit_cast(bf16x8, pw); }
    LAS f32x2* WS = (LAS f32x2*)lds;
    float av[2][16], bv[2][16], sA[2][8], sB[2][8];
#pragma unroll
    for (int cbk = 0; cbk < 2; ++cbk) {
        f32x16 racc = f32x16{}, iacc = f32x16{}, xacc = f32x16{};
        bf16x8 wa[4], wx[4];
#pragma unroll
        for (int ks = 0; ks < 4; ++ks) { const int wo = (32 * cbk + r32) * 144 + (16 * ks + 8 * hi) * 2; wa[ks] = *(const LAS bf16x8*)(lds + LR_WA + wo); wx[ks] = *(const LAS bf16x8*)(lds + LR_WX + wo); }
#pragma unroll
        for (int ks = 0; ks < 4; ++ks) {
            bf16x8 idf;
#pragma unroll
            for (int j = 0; j < 8; ++j) idf[j] = ((16 * ks + 8 * hi + j) == (32 * cbk + r32)) ? (short)0x3F80 : (short)0;
            racc = __builtin_amdgcn_mfma_f32_32x32x16_bf16(afr[ks], wa[ks], racc, 0, 0, 0);
            iacc = __builtin_amdgcn_mfma_f32_32x32x16_bf16(afr[ks], wx[ks], iacc, 0, 0, 0);
            xacc = __builtin_amdgcn_mfma_f32_32x32x16_bf16(afr[ks], idf, xacc, 0, 0, 0); }
        const int chl_ = 32 * cbk + r32; const float bav = ((const LAS float*)(lds + LR_BA))[chl_], bxv = ((const LAS float*)(lds + LR_BX))[chl_], sp8 = ((const LAS float*)(lds + LR_SP))[chl_];
#pragma unroll
        for (int r = 0; r < 16; ++r) { const float rr = sigmoidf_(racc[r] + bav), ig = sigmoidf_(iacc[r] + bxv); const float a = __builtin_amdgcn_exp2f(sp8 * rr);
            float mult = __builtin_amdgcn_sqrtf(fmaxf(__builtin_fmaf(-a, a, 1.0f), 0.f)); if (t0 + crow16(r, hi) == 0) mult = 1.0f;
            av[cbk][r] = a; bv[cbk][r] = mult * ig * xacc[r]; }
        float Aw, Bw; lru_scan_groups(av[cbk], bv[cbk], hi, sA[cbk], sB[cbk], Aw, Bw);
        if (hi == 0) WS[wave * 64 + 32 * cbk + r32] = (f32x2){Aw, Bw};
    }
    LDS_WAIT(); __syncthreads();
    if (next_unit >= 0) lru_tile_load(P, T, next_unit, wave, lane);
    unsigned glv[2][8];
#pragma unroll
    for (int cbk = 0; cbk < 2; ++cbk)
#pragma unroll
        for (int r = 0; r < 16; r += 2) glv[cbk][r >> 1] = (unsigned)__builtin_nontemporal_load(P.GL + (m0 + crow16(r, hi)) * 512 + n * 64 + 32 * cbk + r32) | ((unsigned)__builtin_nontemporal_load(P.GL + (m0 + crow16(r + 1, hi)) * 512 + n * 64 + 32 * cbk + r32) << 16);
    unsigned* cp = cnt + 64 * (b * 8 + n);
    if (wave == 0) {
        float A = 1.f, Bv = 0.f;
#pragma unroll
        for (int w = 0; w < 8; ++w) { const f32x2 ab = WS[w * 64 + lane]; Bv = ab[0] * Bv + ab[1]; A *= ab[0]; }
        __hip_atomic_store((unsigned long long*)(P.SUMM + (size_t)unit * 64 + lane), ((unsigned long long)__float_as_uint(Bv) << 32) | __float_as_uint(A), __ATOMIC_RELAXED, __HIP_MEMORY_SCOPE_AGENT);
        asm volatile("s_waitcnt vmcnt(0)" ::: "memory");
        if (lane == 0) __hip_atomic_fetch_or(cp, 1u << c, __ATOMIC_RELAXED, __HIP_MEMORY_SCOPE_AGENT);
        const unsigned need_ = (1u << c) - 1u; unsigned sp_ = 0;
        while (((unsigned)__builtin_amdgcn_readfirstlane(__hip_atomic_load(cp, __ATOMIC_RELAXED, __HIP_MEMORY_SCOPE_AGENT)) & need_) != need_ && ++sp_ < (1u << 22)) __builtin_amdgcn_s_sleep(1);
        float h = 0.f;
#pragma unroll
        for (int c0 = 0; c0 < 16; c0 += 8) { unsigned long long sm[8];
#pragma unroll
          for (int q = 0; q < 8; ++q) { const int cc = c0 + q; sm[q] = __hip_atomic_load((unsigned long long*)(P.SUMM + (size_t)(unit - c + (cc < c ? cc : 0)) * 64 + lane), __ATOMIC_RELAXED, __HIP_MEMORY_SCOPE_AGENT); }
#pragma unroll
          for (int q = 0; q < 8; ++q) { const int cc = c0 + q; const float A_ = (cc < c) ? __uint_as_float((unsigned)sm[q]) : 1.0f, B_ = (cc < c) ? __uint_as_float((unsigned)(sm[q] >> 32)) : 0.0f; h = A_ * h + B_; } }
        ((LAS float*)(lds + LR_CARRY))[lane] = h;
    }
    LDS_WAIT(); __syncthreads();
#pragma unroll
    for (int cbk = 0; cbk < 2; ++cbk) { const int chl = 32 * cbk + r32;
        float h = ((LAS float*)(lds + LR_CARRY))[chl];
#pragma unroll
        for (int w = 0; w < 7; ++w) { const f32x2 ab = WS[w * 64 + chl]; const float A_ = (w < wave) ? ab[0] : 1.0f, B_ = (w < wave) ? ab[1] : 0.0f; h = A_ * h + B_; }
        float Hs[4];
#pragma unroll
        for (int G = 0; G < 8; ++G) { if ((G & 1) == 0) { if (!hi) Hs[G >> 1] = h; } else { if (hi) Hs[G >> 1] = h; } h = sA[cbk][G] * h + sB[cbk][G]; }
        const int ch = n * 64 + chl;
#pragma unroll
        for (int gq = 0; gq < 4; ++gq) { float hh = Hs[gq];
#pragma unroll
            for (int j = 0; j < 4; j += 2) { const int r = 4 * gq + j; const unsigned gw_ = glv[cbk][r >> 1];
                hh = av[cbk][r] * hh + bv[cbk][r]; const float y0 = hh * gelu_tanh(bf2f(gw_ & 0xffffu));
                hh = av[cbk][r + 1] * hh + bv[cbk][r + 1]; const float y1 = hh * gelu_tanh(bf2f(gw_ >> 16));
                const unsigned wy = cvt_pk_bf16(y0, y1);
                P.Y[(m0 + crow16(r, hi)) * DM + ch] = (bf16_t)(wy & 0xffffu); P.Y[(m0 + crow16(r + 1, hi)) * DM + ch] = (bf16_t)(wy >> 16); } }
    }
    __syncthreads();
}

namespace attn {
using bf16x8_t = bf16x8;
typedef short s16x4 __attribute__((ext_vector_type(4)));
constexpr int D = 64, QP = 512  , NW = 8, QBLK = 32, QB = 256, KVBLK = 64;
constexpr int NSLOT = 3, SLOTB = 8192;
constexpr int LDS_K = 0, LDS_V = NSLOT * SLOTB, LDS_WS = 2 * NSLOT * SLOTB, LDS_OST = LDS_WS + NW * 64 * 4, LDS_BYTES_A = LDS_OST + NW * 4096;
#define SBAR() __builtin_amdgcn_sched_barrier(0)
__device__ __forceinline__ int crow(int r, int hi) { return (r & 3) + 8 * (r >> 2) + 4 * hi; }
__device__ __forceinline__ void cmask(f32x16& p0, f32x16& p1, int jb, int qrel, int hi) {
    const float NEG = -INFINITY; const int kb = 64 * jb + 4 * hi;
#pragma unroll
    for (int r = 0; r < 16; ++r) { const int kv = kb + (r & 3) + 8 * (r >> 2); if (kv > qrel) p0[r] = NEG; if (kv + 32 > qrel) p1[r] = NEG; }
}
__device__ __forceinline__ void glds16(const void* gsrc, unsigned lds_dst) { unsigned keep;
    asm volatile("s_mov_b32 %0, m0\n\ts_mov_b32 m0, %2\n\ts_nop 0\n\tglobal_load_lds_dwordx4 %1, off\n\ts_mov_b32 m0, %0" : "=&s"(keep) : "v"(gsrc), "s"(lds_dst) : "memory"); }
typedef float f32x2_t __attribute__((ext_vector_type(2))); typedef __bf16 bf16x2_t __attribute__((ext_vector_type(2)));
__device__ __forceinline__ unsigned cvtpk_s(float lo, float hi) { f32x2_t v = {lo, hi}; bf16x2_t b = __builtin_convertvector(v, bf16x2_t); return __builtin_bit_cast(unsigned, b); }
#define WAIT_BAR(N) asm volatile("s_waitcnt vmcnt(" #N ") lgkmcnt(0)\n\ts_barrier" ::: "memory")
typedef __attribute__((address_space(3))) const char* lds_cptr;
typedef short v4i16_t __attribute__((ext_vector_type(4)));
__device__ __forceinline__ void kload8(bf16x8* kf, lds_cptr kp) {
    kf[0] = *(const __attribute__((address_space(3))) bf16x8*)(kp);        kf[1] = *(const __attribute__((address_space(3))) bf16x8*)(kp + 512);
    kf[2] = *(const __attribute__((address_space(3))) bf16x8*)(kp + 2048); kf[3] = *(const __attribute__((address_space(3))) bf16x8*)(kp + 2560);
    kf[4] = *(const __attribute__((address_space(3))) bf16x8*)(kp + 4096); kf[5] = *(const __attribute__((address_space(3))) bf16x8*)(kp + 4608);
    kf[6] = *(const __attribute__((address_space(3))) bf16x8*)(kp + 6144); kf[7] = *(const __attribute__((address_space(3))) bf16x8*)(kp + 6656);
}
__device__ __forceinline__ void kload2(bf16x8* kf, lds_cptr kp, int j) { kf[2 * j] = *(const __attribute__((address_space(3))) bf16x8*)(kp + j * 2048); kf[2 * j + 1] = *(const __attribute__((address_space(3))) bf16x8*)(kp + j * 2048 + 512); }
__device__ __forceinline__ s16x4 vtr(lds_cptr p) { return __builtin_bit_cast(s16x4, __builtin_amdgcn_ds_read_tr16_b64_v4i16((__attribute__((address_space(3))) v4i16_t*)p)); }
__device__ __forceinline__ void pv(f32x16* o, int vb, bf16x8 pa0, bf16x8 pa1, bf16x8 pa2, bf16x8 pa3) {
#pragma unroll
    for (int d0 = 0; d0 < 2; ++d0) { s16x4 lo[4], hi[4];
#pragma unroll
        for (int ks = 0; ks < 4; ++ks) {
            asm volatile("ds_read_b64_tr_b16 %0,%1 offset:%c2" : "=&v"(lo[ks]) : "v"(vb), "i"(d0 * 4096 + ks * 1024) : "memory");
            asm volatile("ds_read_b64_tr_b16 %0,%1 offset:%c2" : "=&v"(hi[ks]) : "v"(vb), "i"(d0 * 4096 + ks * 1024 + 512) : "memory"); }
        asm volatile("s_waitcnt lgkmcnt(0)" ::: "memory"); SBAR();
#define PK(k) (bf16x8){lo[k][0], lo[k][1], lo[k][2], lo[k][3], hi[k][0], hi[k][1], hi[k][2], hi[k][3]}
        o[d0] = __builtin_amdgcn_mfma_f32_32x32x16_bf16(pa0, PK(0), o[d0], 0, 0, 0);
        o[d0] = __builtin_amdgcn_mfma_f32_32x32x16_bf16(pa1, PK(1), o[d0], 0, 0, 0);
        o[d0] = __builtin_amdgcn_mfma_f32_32x32x16_bf16(pa2, PK(2), o[d0], 0, 0, 0);
        o[d0] = __builtin_amdgcn_mfma_f32_32x32x16_bf16(pa3, PK(3), o[d0], 0, 0, 0);
#undef PK
    }
}
__device__ __forceinline__ void cinit(f32x16& c0, f32x16& c1, float cbh, float slope2) {
#pragma unroll
    for (int r = 0; r < 16; ++r) { const float kq = (float)((r & 3) + 8 * (r >> 2)); c0[r] = __builtin_fmaf(slope2, kq, cbh); c1[r] = __builtin_fmaf(slope2, kq + 32.0f, cbh); }
}

__device__ __forceinline__ void attn_unit(int b, int h, int qb, const bf16_t* Q, const bf16_t* __restrict__ K, const bf16_t* __restrict__ V, bf16_t* Y, const float* KM, float ref, int t_lo, char* shm, int tid_in) {
    int tid = tid_in; asm volatile("" : "+v"(tid));
    const int lane = tid & 63, r32 = lane & 31, hi = lane >> 5; const int wid = __builtin_amdgcn_readfirstlane(tid >> 6);
    const long rowbase = (long)b * SEQ; const int q0 = qb * QB;
    const bf16_t* Qw = Q + (rowbase + q0 + wid * QBLK) * QP + h * D;
    const bf16_t* Kh = K + (rowbase + (long)t_lo * KVBLK) * QP + h * D; const bf16_t* Vh = V + (rowbase + (long)t_lo * KVBLK) * QP + h * D;
    const unsigned lds0 = (unsigned)(uintptr_t)shm;
    const bf16_t* ksrc = Kh + (long)lane * QP + wid * 8;
    const bf16_t* vsrc = Vh + (long)(16 * (wid & 3) + (lane >> 2)) * QP + (wid >> 2) * 32 + (lane & 3) * 8;
    const unsigned kdst = lds0 + LDS_K + wid * 1024, vdst = lds0 + LDS_V + wid * 1024;
#define DMA_K(t, slot) glds16(ksrc + (long)(t) * KVBLK * QP, (unsigned)__builtin_amdgcn_readfirstlane(kdst + (slot)))
#define DMA_V(t, slot) glds16(vsrc + (long)(t) * KVBLK * QP, (unsigned)__builtin_amdgcn_readfirstlane(vdst + (slot)))
    const int vb0 = (int)(lds0 + LDS_V) + ((lane >> 4) & 1) * 32 + (lane & 3) * 8 + (4 * hi + ((lane & 15) >> 2)) * 64;
    bf16x8 kf[8];
    const lds_cptr shm3 = (lds_cptr)shm; const lds_cptr kp0 = shm3 + LDS_K + hi * 1024 + r32 * 16; const lds_cptr vp0 = shm3 + LDS_V + ((lane >> 4) & 1) * 32 + (lane & 3) * 8 + (4 * hi + ((lane & 15) >> 2)) * 64;
    const int NT = (q0 + QB) / KVBLK - t_lo;
    DMA_K(0, 0); DMA_V(0, 0); DMA_K(1, SLOTB);
    bf16x8 qr[4];
#pragma unroll
    for (int d0 = 0; d0 < 4; ++d0) qr[d0] = *reinterpret_cast<const bf16x8*>(&Qw[(long)r32 * QP + d0 * 16 + hi * 8]);
    unsigned selmask;
    {
        f32x16 gt = f32x16{};
        const float* kmr = KM + ((size_t)(b * NH + h) * 16 + (r32 & 15)) * 64 + 8 * hi;
#pragma unroll
        for (int d0 = 0; d0 < 4; ++d0) {
            f32x4 k0 = *(const f32x4*)(kmr + 16 * d0), k1 = *(const f32x4*)(kmr + 16 * d0 + 4);
            if (r32 >= 16) { k0 = (f32x4){0.f, 0.f, 0.f, 0.f}; k1 = k0; }
            u32x4 wh, wl; float lo8[8], x8[8] = {k0[0], k0[1], k0[2], k0[3], k1[0], k1[1], k1[2], k1[3]}; unsigned hb[8];
#pragma unroll
            for (int j = 0; j < 8; ++j) { hb[j] = f2bf(x8[j]); lo8[j] = x8[j] - bf2f(hb[j]); }
            wh.x = hb[0] | (hb[1] << 16); wh.y = hb[2] | (hb[3] << 16); wh.z = hb[4] | (hb[5] << 16); wh.w = hb[6] | (hb[7] << 16);
            wl.x = pk2(lo8[0], lo8[1]); wl.y = pk2(lo8[2], lo8[3]); wl.z = pk2(lo8[4], lo8[5]); wl.w = pk2(lo8[6], lo8[7]);
            gt = __builtin_amdgcn_mfma_f32_32x32x16_bf16(__builtin_bit_cast(bf16x8, wh), qr[d0], gt, 0, 0, 0);
            gt = __builtin_amdgcn_mfma_f32_32x32x16_bf16(__builtin_bit_cast(bf16x8, wl), qr[d0], gt, 0, 0, 0);
        }
        float g[16];
#pragma unroll
        for (int r = 0; r < 8; ++r) { const float mine = gt[r], oth = __shfl_xor(mine, 32); const int nb = (r & 3) + 8 * (r >> 2);
            g[nb] = hi ? oth : mine; g[nb + 4] = hi ? mine : oth; }
#pragma unroll
        for (int n = 0; n < 16; ++n) if (n >= qb) g[n] = -3.0e38f;
        unsigned m = 0;
#pragma unroll
        for (int s = 0; s < 3; ++s) { float best = g[0]; int bi = 0;
#pragma unroll
            for (int n = 1; n < 16; ++n) if (g[n] > best) { best = g[n]; bi = n; }
            m |= 1u << bi;
#pragma unroll
            for (int n = 0; n < 16; ++n) if (n == bi) g[n] = -INFINITY; }
        selmask = (qb <= 3) ? ((1u << qb) - 1u) : m;
    }
    const float slope2 = __builtin_amdgcn_exp2f(-(float)(h + 1)) * LOG2E;
    const int qrel = wid * QBLK + r32;
    const float tqf = (float)(q0 + qrel);
#define CBH(t) ((((t) >= NT - 4) || ((selmask >> (((t) + t_lo) >> 2)) & 1u)) ? __builtin_fmaf(slope2, (float)(64 * ((t) + t_lo) + 4 * hi) - tqf, -ref) : -1.0e30f)
    float l_reg = 0.f; f32x16 o[2]; o[0] = f32x16{}; o[1] = f32x16{};
#define CMASK(P0, P1, t) do { int jb_ = (t) - (NT - 4); if (jb_ >= 0) cmask(P0, P1, jb_, qrel, hi); } while (0)
    f32x16 pA0, pA1, pB0, pB1;
    int sl_prev = 0, sl_cur = 0, sl_next = SLOTB;
#define ROT() do { sl_prev = sl_cur; sl_cur = sl_next; sl_next = (sl_next == (NSLOT - 1) * SLOTB) ? 0 : sl_next + SLOTB; } while (0)
    DMA_K(2, 2 * SLOTB);
    cinit(pA0, pA1, CBH(0), slope2);
    WAIT_BAR(3);
    { const char* kb = shm + LDS_K + hi * 1024 + r32 * 16;
#pragma unroll
      for (int d0 = 0; d0 < 4; ++d0) { const bf16x8 b0 = *reinterpret_cast<const bf16x8*>(kb + d0 * 2048); const bf16x8 b1 = *reinterpret_cast<const bf16x8*>(kb + d0 * 2048 + 512);
          pA0 = __builtin_amdgcn_mfma_f32_32x32x16_bf16(b0, qr[d0], pA0, 0, 0, 0); pA1 = __builtin_amdgcn_mfma_f32_32x32x16_bf16(b1, qr[d0], pA1, 0, 0, 0); } }
    CMASK(pA0, pA1, 0);
#pragma unroll
    for (int r = 0; r < 16; ++r) { pA0[r] = __builtin_amdgcn_exp2f(pA0[r]); pA1[r] = __builtin_amdgcn_exp2f(pA1[r]); }
    WAIT_BAR(0);
    DMA_K(3, 0); DMA_V(1, SLOTB);
    ROT();
    kload8(kf, kp0 + sl_cur);
    WAIT_BAR(2);
    s16x4 vlo[8], vhi[8]; u32x4 pw0, pw1, pw2, pw3;
#define PKW(P, B) cvtpk_s(P[B], P[B + 1])
#define PAF(k) __builtin_bit_cast(bf16x8, pw##k)
#define VFR(i) (bf16x8){vlo[i][0], vlo[i][1], vlo[i][2], vlo[i][3], vhi[i][0], vhi[i][1], vhi[i][2], vhi[i][3]}
#define PIN(x) asm volatile("" : "+v"(x))
#define GAPA(MF, A0, A1, A2, A3, W0, W1, PW) do { MF; sacc += A0; sacc += A1; sacc += A2; sacc += A3; PIN(sacc); W0; W1; PIN(PW); SBAR(); } while (0)
#define EX(v) __builtin_amdgcn_exp2f(v)
#define GAPB(MF, X, B) do { MF; X[B] = EX(X[B]); X[B + 1] = EX(X[B + 1]); X[B + 2] = EX(X[B + 2]); X[B + 3] = EX(X[B + 3]); PIN(X); SBAR(); } while (0)
#define VRD(i) do { vlo[i] = vtr(vp_ + (((i) >> 2) * 4096 + ((i) & 3) * 1024)); vhi[i] = vtr(vp_ + (((i) >> 2) * 4096 + ((i) & 3) * 1024 + 512)); } while (0)
#define KRD(G, j) do { if (G) { kload2(kf, kp0 + sl_next, j); SBAR(); } } while (0)
#define STEP(C0, C1, P0, P1, t, GK, GV, GL) do { SBAR(); \
    cinit(C0, C1, CBH(t), slope2); SBAR(); \
    const lds_cptr vp_ = vp0 + sl_prev; \
    VRD(0); SBAR(); float sacc = (P0[0] + P0[1]); \
    GAPA(C0 = __builtin_amdgcn_mfma_f32_32x32x16_bf16(kf[0], qr[0], C0, 0, 0, 0), P0[2], P0[3], P0[4], P0[5],     pw0[0] = PKW(P0, 0), pw0[1] = PKW(P0, 2), pw0); \
    VRD(4); SBAR(); GAPA(C1 = __builtin_amdgcn_mfma_f32_32x32x16_bf16(kf[1], qr[0], C1, 0, 0, 0), P0[6], P0[7], P0[8], P0[9],     pw0[2] = PKW(P0, 4), pw0[3] = PKW(P0, 6), pw0); \
    VRD(1); SBAR(); GAPA(C0 = __builtin_amdgcn_mfma_f32_32x32x16_bf16(kf[2], qr[1], C0, 0, 0, 0), P0[10], P0[11], P0[12], P0[13], pw1[0] = PKW(P0, 8), pw1[1] = PKW(P0, 10), pw1); \
    VRD(5); SBAR(); GAPA(C1 = __builtin_amdgcn_mfma_f32_32x32x16_bf16(kf[3], qr[1], C1, 0, 0, 0), P0[14], P0[15], P1[0], P1[1],   pw1[2] = PKW(P0, 12), pw1[3] = PKW(P0, 14), pw1); \
    VRD(2); SBAR(); GAPA(C0 = __builtin_amdgcn_mfma_f32_32x32x16_bf16(kf[4], qr[2], C0, 0, 0, 0), P1[2], P1[3], P1[4], P1[5],     pw2[0] = PKW(P1, 0), pw2[1] = PKW(P1, 2), pw2); \
    VRD(6); SBAR(); GAPA(C1 = __builtin_amdgcn_mfma_f32_32x32x16_bf16(kf[5], qr[2], C1, 0, 0, 0), P1[6], P1[7], P1[8], P1[9],     pw2[2] = PKW(P1, 4), pw2[3] = PKW(P1, 6), pw2); \
    VRD(3); SBAR(); GAPA(C0 = __builtin_amdgcn_mfma_f32_32x32x16_bf16(kf[6], qr[3], C0, 0, 0, 0), P1[10], P1[11], P1[12], P1[13], pw3[0] = PKW(P1, 8), pw3[1] = PKW(P1, 10), pw3); \
    VRD(7); SBAR(); GAPA(C1 = __builtin_amdgcn_mfma_f32_32x32x16_bf16(kf[7], qr[3], C1, 0, 0, 0), P1[14], P1[15], 0.f, 0.f,       pw3[2] = PKW(P1, 12), pw3[3] = PKW(P1, 14), pw3); \
    l_reg += sacc; \
    if (GK) { DMA_K((t) + 3, sl_cur); } if (GV) { DMA_V((t) + 1, sl_next); } \
    CMASK(C0, C1, t); \
    SBAR(); \
    GAPB(o[0] = __builtin_amdgcn_mfma_f32_32x32x16_bf16(PAF(0), VFR(0), o[0], 0, 0, 0), C0, 0); \
    GAPB(o[1] = __builtin_amdgcn_mfma_f32_32x32x16_bf16(PAF(0), VFR(4), o[1], 0, 0, 0), C0, 4); \
    KRD(GL, 0); GAPB(o[0] = __builtin_amdgcn_mfma_f32_32x32x16_bf16(PAF(1), VFR(1), o[0], 0, 0, 0), C0, 8); \
    KRD(GL, 1); GAPB(o[1] = __builtin_amdgcn_mfma_f32_32x32x16_bf16(PAF(1), VFR(5), o[1], 0, 0, 0), C0, 12); \
    KRD(GL, 2); GAPB(o[0] = __builtin_amdgcn_mfma_f32_32x32x16_bf16(PAF(2), VFR(2), o[0], 0, 0, 0), C1, 0); \
    KRD(GL, 3); GAPB(o[1] = __builtin_amdgcn_mfma_f32_32x32x16_bf16(PAF(2), VFR(6), o[1], 0, 0, 0), C1, 4); \
    GAPB(o[0] = __builtin_amdgcn_mfma_f32_32x32x16_bf16(PAF(3), VFR(3), o[0], 0, 0, 0), C1, 8); \
    GAPB(o[1] = __builtin_amdgcn_mfma_f32_32x32x16_bf16(PAF(3), VFR(7), o[1], 0, 0, 0), C1, 12); \
    } while (0)
    int t = 1;
#undef CMASK
#define CMASK(P0, P1, t) do {} while (0)
    for (; t + 5 < NT; t += 2) {
        STEP(pB0, pB1, pA0, pA1, t, true, true, true);     WAIT_BAR(2); ROT();
        STEP(pA0, pA1, pB0, pB1, t + 1, true, true, true); WAIT_BAR(2); ROT();
    }
#undef CMASK
#define CMASK(P0, P1, t) do { int jb_ = (t) - (NT - 4); if (jb_ >= 0) cmask(P0, P1, jb_, qrel, hi); } while (0)
#define ENDW(tt) do { if ((tt) + 3 < NT) { WAIT_BAR(2); } else if ((tt) + 2 < NT) { WAIT_BAR(1); } else { WAIT_BAR(0); } } while (0)
    for (; t + 1 < NT; t += 2) {
        STEP(pB0, pB1, pA0, pA1, t, (t + 3 < NT), (t + 1 < NT), (t + 1 < NT));         ENDW(t);     ROT();
        STEP(pA0, pA1, pB0, pB1, t + 1, (t + 4 < NT), (t + 2 < NT), (t + 2 < NT));     ENDW(t + 1); ROT();
    }
    STEP(pB0, pB1, pA0, pA1, NT - 1, false, false, false);
    { float sacc = pB0[0] + pB0[1];
#pragma unroll
      for (int r = 2; r < 16; ++r) sacc += pB0[r];
#pragma unroll
      for (int r = 0; r < 16; ++r) sacc += pB1[r];
      l_reg += sacc;
      pw0 = (u32x4){PKW(pB0, 0), PKW(pB0, 2), PKW(pB0, 4), PKW(pB0, 6)}; pw1 = (u32x4){PKW(pB0, 8), PKW(pB0, 10), PKW(pB0, 12), PKW(pB0, 14)};
      pw2 = (u32x4){PKW(pB1, 0), PKW(pB1, 2), PKW(pB1, 4), PKW(pB1, 6)}; pw3 = (u32x4){PKW(pB1, 8), PKW(pB1, 10), PKW(pB1, 12), PKW(pB1, 14)};
      SBAR(); pv(o, vb0 + sl_cur, PAF(0), PAF(1), PAF(2), PAF(3)); }
#undef PKW
#undef PAF
#undef VFR
#undef PIN
#undef GAPA
#undef GAPB
#undef EX
#undef VRD
#undef KRD
#undef STEP
#undef ENDW
    { l_reg += __shfl_xor(l_reg, 32); }
    float* wsf = (float*)(shm + LDS_WS) + wid * 64;
    if (hi == 0) wsf[32 + r32] = l_reg; asm volatile("s_waitcnt lgkmcnt(0)" ::: "memory");
    float rli[16];
#pragma unroll
    for (int r = 0; r < 16; ++r) rli[r] = __builtin_amdgcn_rcpf(wsf[32 + crow(r, hi)]);
    bf16_t* Ow = Y + (rowbase + q0 + wid * QBLK) * DM + 512 + h * D;
    { bf16_t* stg = (bf16_t*)(shm + LDS_OST) + wid * 2048;
#pragma unroll
      for (int r = 0; r < 16; ++r) { const int orow = crow(r, hi);
#pragma unroll
          for (int d0 = 0; d0 < 2; ++d0) stg[orow * 64 + d0 * 32 + r32] = (bf16_t)f2bf(o[d0][r] * rli[r]); }
      asm volatile("s_waitcnt lgkmcnt(0)" ::: "memory");
#pragma unroll
      for (int i = 0; i < 4; ++i) { const int row = i * 8 + (lane >> 3), ch = lane & 7; const u32x4 v = *(const u32x4*)(stg + row * 64 + ch * 8); *(u32x4*)(Ow + (long)row * DM + ch * 8) = v; } }
    asm volatile("s_waitcnt lgkmcnt(0)\n\ts_barrier" ::: "memory");
#undef DMA_K
#undef DMA_V
#undef CMASK
#undef CBH
#undef ROT
}
#undef SBAR
#undef WAIT_BAR
}

__device__ constexpr int PROBE_REP[9] = {1, 1, 1, 1, 1, 1, 1, 1, 1};
#define WSP(T, off) ((T*)(a.ws + (off)))
#define P_WT_in WSP(bf16_t, WS_WIN)
#define P_WT_out WSP(bf16_t, WS_WOUT)
#define P_WT_up WSP(bf16_t, WS_WUP)
#define P_WT_dn WSP(bf16_t, WS_WDN)
#define P_WT_g WSP(bf16_t, WS_WG)
#define P_WT_p WSP(bf16_t, WS_WP)
#define P_GW WSP(bf16_t, WS_GW)
#define P_XN WSP(bf16_t, WS_XN)
#define P_PB WSP(bf16_t, WS_PB)
#define P_PRJ WSP(bf16_t, WS_PRJ)
#define CLS_ ((size_t)(blockIdx.x & 7u))
#define P_XL ((bf16_t*)(a.ws + WS_R + CLS_ * SLAB) - CLS_ * SEQ * 512)
#define P_GL (P_XL + (size_t)SEQ * 512)
#define P_Q (P_XL + (size_t)SEQ * 1024)
#define P_K (P_XL + (size_t)SEQ * 1536)
#define P_V (P_XL + (size_t)SEQ * 2048)
#define P_Y ((bf16_t*)(a.ws + WS_R + CLS_ * SLAB + 20 * MiB) - CLS_ * SEQ * DM)
#define P_RINV0 WSP(float, WS_RINV0)
#define P_XB1 ((bf16_t*)(a.ws + WS_R + CLS_ * SLAB) - CLS_ * SEQ * DM)
#define P_XB2 P_XN
#define P_ACT ((bf16_t*)(a.ws + WS_R + CLS_ * SLAB + 8 * MiB) - CLS_ * SEQ * DFF)
#define P_KM WSP(float, WS_KM)
#define P_SS1 WSP(float, WS_SS1)
#define P_SS2 WSP(float, WS_SS2)
#define P_GT WSP(float, WS_GT)
#define P_PART WSP(float, WS_PART)
#define P_VH WSP(float, WS_VH)
__global__ void __launch_bounds__(512, 2) mega(Args a) {
    extern __shared__ __attribute__((aligned(16))) unsigned char lds_raw[];
    LAS unsigned char* const ldsb = (LAS unsigned char*)lds_raw;
    const int wave_s = __builtin_amdgcn_readfirstlane((int)threadIdx.x >> 6);
    volatile LAS unsigned* MISC = (volatile LAS unsigned*)(ldsb + MISC_OFF);
    for (int u = threadIdx.x; u < (LDS_BYTES - RING_BYTES) / 4; u += NWAVES * 64) ((LAS unsigned*)(ldsb + RING_BYTES))[u] = 0u;
    __syncthreads();
    XcdBarrier bar = xcd_barrier_post((unsigned*)(a.ws + WS_CTL), MISC + 8);
    if (gridDim.x != 256u) __builtin_trap();
    const int lo = a.ph_lo, hi_ = a.ph_hi;
#define IN(k) (lo <= (k) && (k) < hi_)
#define REPEAT(k) for (int rep_ = 0; rep_ < PROBE_REP[k]; ++rep_)
#define SEAM(k) do { if (IN(k) && IN((k) + 1)) xcd_barrier(bar); } while (0)
#define PHASE_IDS() int lane_; asm volatile("v_mbcnt_lo_u32_b32 %0, -1, 0\n\tv_mbcnt_hi_u32_b32 %0, -1, %0" : "=&v"(lane_)); const int tid = wave_s * 64 + lane_; const int lane = tid & 63, wave = wave_s; \
    const int G = gridDim.x, vcu = (G % 8 == 0) ? ((int)blockIdx.x % 8) * (G / 8) + (int)blockIdx.x / 8 : (int)blockIdx.x; const int gw = vcu * NWAVES + wave, NGW = G * NWAVES; (void)lane; (void)gw; (void)NGW;

    REPEAT(0) { if (rep_) xcd_barrier(bar);
    if (IN(0)) {
        PHASE_IDS();
        LAS float* scr = (LAS float*)(ldsb + wave * 16384);
        constexpr int I_IN = (DM / 64) * (INW / 32), I_OUT = (DM / 64) * (DM / 32), I_UP = (DM / 64) * (2 * DFF / 32), I_DN = (DFF / 64) * (DM / 32), I_G = I_OUT, I_P = (PLE / 64) * (DM / 32), I_GW = 16 * 2;
        constexpr int NITEMS = I_IN + I_OUT + I_UP + I_DN + I_G + I_P + I_GW;
        for (int it = gw; it < NITEMS; it += NGW) {
            int r = it;
            if (r < I_IN) { p0_transpose_item(a.in[3], INW, INW, P_WT_in, DM, nullptr, scr, r, lane); continue; } r -= I_IN;
            if (r < I_OUT) { p0_transpose_item(a.in[13], DM, DM, P_WT_out, DM, nullptr, scr, r, lane); continue; } r -= I_OUT;
            if (r < I_UP) { p0_transpose_item(a.in[15], 2 * DFF, 2 * DFF, P_WT_up, DM, a.in[14], scr, r, lane); continue; } r -= I_UP;
            if (r < I_DN) { p0_transpose_item(a.in[18], DM, DM, P_WT_dn, DFF, nullptr, scr, r, lane); continue; } r -= I_DN;
            if (r < I_G) { p0_transpose_item(a.in[20], DM, DM, P_WT_g, DM, a.in[19], scr, r, lane); continue; } r -= I_G;
            if (r < I_P) { p0_transpose_item(a.in[21], DM, DM, P_WT_p, PLE, nullptr, scr, r, lane); continue; } r -= I_P;
            { const int mat = r >> 1, sub = r & 1, gsel = mat >> 3, blk = mat & 7;
              p0_transpose_item((gsel ? a.in[8] : a.in[6]) + (size_t)blk * 4096, 64, 64, P_GW + (size_t)gsel * 32768 + (size_t)blk * 4096, 64, nullptr, scr, sub, lane); }
        }
        VM_WAIT(); __syncthreads();
        if (tid == 0) (void)xb_add((unsigned*)(a.ws + WS_CTL) + GB_WCNT, 1u);
        const int cls = vcu >> 5, cw = (vcu & 31) * NWAVES + wave;
        { const int i = cw * 64 + lane; if (i < NH * 16 * 64) P_KM[cls * (NH * 16 * 64) + i] = 0.f; }
        { const float* xin = a.in[0]; const f32x4* gr = (const f32x4*)a.in[2] + lane; bf16_t* xn = P_XN; float* rinv = P_RINV0;
          f32x4 gg[4];
#pragma unroll
          for (int j = 0; j < 4; ++j) gg[j] = gr[64 * j];
          constexpr int CNW = 32 * NWAVES; const int mend = (cls + 1) * SEQ;
          for (int m0 = cls * SEQ + cw; m0 < mend; m0 += 4 * CNW) {
              f32x4 v[4][4];
#pragma unroll
              for (int r = 0; r < 4; ++r) { const int m = m0 + r * CNW; const f32x4* xr = (const f32x4*)(xin + (size_t)(m < mend ? m : m0) * DM) + lane;
#pragma unroll
                  for (int j = 0; j < 4; ++j) v[r][j] = __builtin_nontemporal_load(xr + 64 * j); }
#pragma unroll
              for (int r = 0; r < 4; ++r) { const int m = m0 + r * CNW; float s = 0.f;
#pragma unroll
                  for (int j = 0; j < 4; ++j) s += (v[r][j][0] * v[r][j][0] + v[r][j][1] * v[r][j][1]) + (v[r][j][2] * v[r][j][2] + v[r][j][3] * v[r][j][3]);
                  const float ms = wave_sum(s) * (1.0f / DM) + EPS; const float rstd = rsqrtf(ms);
                  if (m < mend) { if (lane == 0) rinv[m] = ms * rstd;
                      unsigned long long* o8 = (unsigned long long*)(xn + (size_t)m * DM) + lane;
#pragma unroll
                      for (int j = 0; j < 4; ++j) o8[64 * j] = (unsigned long long)pk2(v[r][j][0] * rstd * gg[j][0], v[r][j][1] * rstd * gg[j][1]) | ((unsigned long long)pk2(v[r][j][2] * rstd * gg[j][2], v[r][j][3] * rstd * gg[j][3]) << 32); } } } }
        { const f32x4* pin = (const f32x4*)a.in[1]; unsigned long long* pb = (unsigned long long*)P_PB; const size_t n4 = (size_t)(cls + 1) * SEQ * PLE / 4, st = (size_t)32 * NWAVES * 64;
          for (size_t i0 = (size_t)cls * SEQ * PLE / 4 + (size_t)cw * 64 + lane; i0 < n4; i0 += 8 * st) { f32x4 v[8];
#pragma unroll
              for (int q = 0; q < 8; ++q) { const size_t i = i0 + q * st; v[q] = __builtin_nontemporal_load(pin + (i < n4 ? i : i0)); }
#pragma unroll
              for (int q = 0; q < 8; ++q) { const size_t i = i0 + q * st; if (i < n4) pb[i] = (unsigned long long)pk2(v[q][0], v[q][1]) | ((unsigned long long)pk2(v[q][2], v[q][3]) << 32); } } }
    }
    }
    if (IN(0) && IN(1)) {
        if (threadIdx.x == 0) { unsigned* bar_ = (unsigned*)(a.ws + WS_CTL); XB_SPIN(xb_ld(&bar_[GB_WCNT]) < gridDim.x, bar_); }
        grp_barrier((unsigned*)(a.ws + WS_CTL), MISC + 10); }
    REPEAT(1) { if (rep_) xcd_barrier(bar);
    if (IN(1)) {
        { PHASE_IDS(); pg8::Gemm g{P_XN, P_WT_in, 0, MTOK, INW, DM, 0}; pg8::StaticOrder S; S.init(MTOK, INW, G, (int)blockIdx.x); EpiInProj E{P_XL, a.in[11], a.in[12], P_KM};
          pg8::gemm_phase<EpiInProj, true>(ldsb, g, S, E, tid); }
        { PHASE_IDS(); pg8::Gemm g{P_PB, P_WT_p, 0, MTOK, DM, PLE, 0}; pg8::StaticOrder S; S.init(MTOK, DM, G, (int)blockIdx.x); EpiBf16Plain E{P_PRJ, 0};
          pg8::gemm_phase<EpiBf16Plain, true>(ldsb, g, S, E, tid); }
    }
    }
    do { if (IN(1) && IN(3)) grp_barrier((unsigned*)(a.ws + WS_CTL), MISC + 10); } while (0);
    REPEAT(3) { if (rep_) xcd_barrier(bar);
    if (IN(3)) {
        { PHASE_IDS(); unsigned* cntL = (unsigned*)(a.ws + WS_CTL) + 4096;
          const LruP LP{P_XL, P_GL, a.in[4], a.in[5], P_GW, P_GW + 32768, a.in[7], a.in[9], a.in[10], WSP(f32x2, WS_SUMM), P_Y, (unsigned*)a.out};
          {
            const int l_ = vcu & 31, u0 = ((vcu >> 5) << 7) | ((l_ >> 2) << 4) | (l_ & 3);
            lru_setup(LP, ldsb, l_ >> 2, tid);
            LruTile T; lru_tile_load(LP, T, u0, wave, lane);
#pragma nounroll
            for (int u = u0; u < u0 + 16; u += 4) lru_unit_fused(LP, ldsb, cntL, T, u, (u + 4 < u0 + 16) ? u + 4 : -1, wave, lane); } }
        { PHASE_IDS();
          float mq = fabsf(a.in[11][lane]), mk = fabsf(a.in[12][lane]); mq = wave_max(mq); mk = wave_max(mk);
          const float ref = C2 * 64.0f * mq * mk;
          LAS int* QL = (LAS int*)(ldsb + attn::LDS_BYTES_A);
#define ATT_TLO(h_, qb_) ({ const float ds_ = (2.0f * ref + 40.0f) / (exp2f(-(float)((h_) + 1)) * LOG2E); const float sm_ = (float)((qb_) * 256) - ds_; int tl_ = sm_ > 0.f ? (int)(sm_ * (1.0f / 64.0f)) : 0; tl_ &= ~1; tl_ = tl_ > 4 * (qb_) ? 4 * (qb_) : tl_; tl_; })
          if (tid < 128) QL[tid] = 4 * ((tid & 15) + 1) - ATT_TLO(tid >> 4, tid & 15);
          __syncthreads();
          if (tid < 128) { const int my = QL[tid]; int rank = 0; for (int j = 0; j < 128; ++j) { const int cj = QL[j]; rank += (cj > my || (cj == my && j < tid)) ? 1 : 0; } QL[128 + rank] = tid; }
          __syncthreads();
          unsigned* qctr = (unsigned*)(a.ws + WS_CTL) + 8192 + 64 * ((int)blockIdx.x & 7);
          for (;;) {
              if (tid == 0) QL[256] = (int)__hip_atomic_fetch_add(qctr, 1u, __ATOMIC_RELAXED, __HIP_MEMORY_SCOPE_AGENT);
              __syncthreads();
              const int k = QL[256];
              __syncthreads();
              if (k >= NH * 16) break;
              const int combo = __builtin_amdgcn_readfirstlane(QL[128 + k]), b = (int)blockIdx.x & 7, h = combo >> 4, qb = combo & 15;
              const int tlo = __builtin_amdgcn_readfirstlane(ATT_TLO(h, qb));
              attn::attn_unit(b, h, qb, P_Q, P_K, P_V, P_Y, P_KM, ref, tlo, (char*)lds_raw, tid); }
#undef ATT_TLO
        }
    }
    }
    do { if (IN(3) && IN(4)) grp_barrier((unsigned*)(a.ws + WS_CTL), MISC + 10); } while (0);
    REPEAT(4) { if (rep_) xcd_barrier(bar);
    if (IN(4)) { PHASE_IDS(); pg8::Gemm g{P_Y, P_WT_out, 0, MTOK, DM, DM, 0}; pg8::StaticOrder S; S.init(MTOK, DM, G, (int)blockIdx.x); EpiResid<2> E{P_XN, P_XB1, P_SS1, P_RINV0, a.in[2]};
        pg8::gemm_phase<EpiResid<2>, true>(ldsb, g, S, E, tid); }
    }
    do { if (IN(4) && IN(5)) grp_barrier((unsigned*)(a.ws + WS_CTL), MISC + 10); } while (0);
    REPEAT(5) { if (rep_) xcd_barrier(bar);
    if (IN(5)) { PHASE_IDS(); pg8::Gemm g{P_XB1, P_WT_up, (size_t)DFF * DM * 2, MTOK, 2 * DFF, DM, 0}; pg8::StaticOrder S; S.init(MTOK, 2 * DFF, G, (int)blockIdx.x);
        pg8::Unit u0, u1; const int nun = (S.nwg - (int)blockIdx.x + G - 1) / G; S.next(0, u0); S.next(nun - 1, u1);
        { const int row = (tid < 256 ? u0.pm : u1.pm) * 256 + (tid & 255); const f32x4* sp = (const f32x4*)(P_SS1 + (size_t)row * 16); const f32x4 p0 = sp[0], p1 = sp[1], p2 = sp[2], p3 = sp[3];
          const float s = ((p0[0] + p0[1]) + (p0[2] + p0[3])) + ((p1[0] + p1[1]) + (p1[2] + p1[3])) + (((p2[0] + p2[1]) + (p2[2] + p2[3])) + ((p3[0] + p3[1]) + (p3[2] + p3[3])));
          ((LAS float*)(ldsb + SPARE_RS))[tid] = rsqrtf(s * (1.0f / DM) + EPS); }
        __syncthreads();
        bool two = true; { pg8::Unit uq; for (int i_ = 0; S.next(i_, uq); ++i_) two = two && (uq.pm == u0.pm || uq.pm == u1.pm); }
        EpiUpFused E{P_ACT, a.in[16], a.in[17], P_GT, P_PART, P_VH, P_SS1, u0.pm, two ? u1.pm : -1};
        pg8::gemm_phase<EpiUpFused, true>(ldsb, g, S, E, tid); }
    }
    do { if (IN(5) && IN(7)) grp_barrier((unsigned*)(a.ws + WS_CTL), MISC + 10); } while (0);
    if (IN(7)) { PHASE_IDS(); pg8::Gemm g{P_ACT, P_WT_dn, 0, MTOK, DM, DFF, 0}; pg8::StaticOrder S; S.init(MTOK, DM, G, (int)blockIdx.x);
        { const float* GT = P_GT; const float* PART = P_PART; const float* VH = P_VH; const float* fcw = a.in[16]; bf16_t* ACT = P_ACT;
          pg8::Unit uu; for (int ui_ = 0; S.next(ui_, uu); ++ui_) {
#pragma unroll
              for (int it_ = 0; it_ < 4 * (DFF / 4) / (NWAVES * 64); ++it_) { const int i = tid + it_ * NWAVES * 64; const int c4 = i % (DFF / 4), sr4 = i / (DFF / 4), rr = sr4 & 1, strip = uu.pm * 2 + (sr4 >> 1), sr = strip * 2 + rr, j = c4 * 4, r0 = strip * 128;
                  f32x4 pre = __builtin_nontemporal_load((const f32x4*)(PART + (size_t)sr * DFF + j)); const f32x4 v = __builtin_nontemporal_load((const f32x4*)(VH + (size_t)sr * DFF + j));
                  if ((r0 & (SEQ - 1)) != 0) { const f32x4 p2 = *(const f32x4*)(GT + ((size_t)(strip - 1) * 2 + 0) * DFF + j), p1 = *(const f32x4*)(GT + ((size_t)(strip - 1) * 2 + 1) * DFF + j);
                      const f32x4 w0 = *(const f32x4*)(fcw + j), w1 = *(const f32x4*)(fcw + DFF + j);
                      if (rr == 0) pre = pre + w0 * p2 + w1 * p1; else pre = pre + w0 * p1; }
                  u32x2 w; w.x = pk2(gelu_tanh(pre[0]) * v[0], gelu_tanh(pre[1]) * v[1]); w.y = pk2(gelu_tanh(pre[2]) * v[2], gelu_tanh(pre[3]) * v[3]);
                  *(u32x2*)(ACT + (size_t)(r0 + rr) * DFF + j) = w; } }
          VM_WAIT(); __syncthreads(); }
        EpiResid<1> E{P_XB1, P_XB2, P_SS2, nullptr, nullptr};
        pg8::gemm_phase<EpiResid<1>, true>(ldsb, g, S, E, tid); }
    do { if (IN(7) && IN(8)) grp_barrier((unsigned*)(a.ws + WS_CTL), MISC + 10); } while (0);
    if (IN(8)) { PHASE_IDS(); pg8::Gemm g{P_XB2, P_WT_g, 0, MTOK, DM, DM, 0}; pg8::StaticOrder S; S.init(MTOK, DM, G, (int)blockIdx.x); EpiFinal E{a.out, P_XB2, P_PRJ, P_SS2};
        pg8::gemm_phase<EpiFinal, true>(ldsb, g, S, E, tid); }
#undef IN
#undef SEAM
}

#ifndef MK_N_LAUNCHES
#define MK_N_LAUNCHES 1
#endif
constexpr int N_PHASES = 9;
extern "C" void kernel_launch(void* const* d_in, const int* in_sizes, int n_in, void* d_out, int out_size, void* d_ws, size_t ws_size, hipStream_t stream) {
    static int grid = 0;
    if (grid == 0) {
        if (n_in != 22 || ws_size < WS_END || out_size != MTOK * DM) { fprintf(stderr, "kernel_launch: unexpected n_in %d, out_size %d or ws_size %zu\n", n_in, out_size, ws_size); grid = -1; return; }
        int dev = 0, cus = 0, per_cu = 0;
        if (hipGetDevice(&dev) != hipSuccess || hipDeviceGetAttribute(&cus, hipDeviceAttributeMultiprocessorCount, dev) != hipSuccess) { grid = -1; return; }
        if (hipFuncSetAttribute((const void*)mega, hipFuncAttributeMaxDynamicSharedMemorySize, LDS_BYTES) != hipSuccess) { fprintf(stderr, "kernel_launch: hipFuncSetAttribute failed\n"); grid = -1; return; }
        if (hipOccupancyMaxActiveBlocksPerMultiprocessor(&per_cu, (const void*)mega, NWAVES * 64, LDS_BYTES) != hipSuccess || per_cu < 1) fprintf(stderr, "kernel_launch: occupancy query says %d\n", per_cu);
        (void)hipGetLastError();
        grid = cus >= 128 ? (cus / 128) * 128 : cus;
    }
    if (grid < 0) return;
    (void)hipMemsetAsync((char*)d_ws + WS_CTL, 0, CTL_ZERO_BYTES, stream);
    Args a{};
    for (int i = 0; i < 22; ++i) a.in[i] = (const float*)d_in[i];
    a.out = (float*)d_out; a.ws = (unsigned char*)d_ws;
    if (MK_N_LAUNCHES == 1) { a.ph_lo = 0; a.ph_hi = N_PHASES; hipLaunchKernelGGL(mega, dim3(grid), dim3(NWAVES * 64), LDS_BYTES, stream, a); }
    else { for (int ph = 0; ph < N_PHASES; ++ph) { a.ph_lo = ph; a.ph_hi = ph + 1; hipLaunchKernelGGL(mega, dim3(grid), dim3(NWAVES * 64), LDS_BYTES, stream, a); } }
}
```

```cpp
#include <hip/hip_runtime.h>
#include <cstdio>
#include <cstdint>

constexpr int BATCH = 8, SEQ = 4096, DM = 1024, MTOK = BATCH * SEQ;
constexpr int LRU_W = 512, ATT_W = 512, NH = 8, HD = 64, INW = 2560, DFF = 3072, PLE = 256;
constexpr float EPS = 1e-6f;
constexpr float LOG2E = 1.4426950408889634f;
constexpr float C2 = 0.125f * LOG2E;

typedef unsigned short bf16_t;
typedef short bf16x8 __attribute__((ext_vector_type(8)));
typedef float f32x4 __attribute__((ext_vector_type(4)));
typedef float f32x2 __attribute__((ext_vector_type(2)));
typedef unsigned u32x4 __attribute__((ext_vector_type(4)));
typedef unsigned u32x2 __attribute__((ext_vector_type(2)));

__device__ __forceinline__ unsigned f2bf(float f) { unsigned u = __builtin_bit_cast(unsigned, f); return (u + 0x7fffu + ((u >> 16) & 1u)) >> 16; }
__device__ __forceinline__ unsigned pk2(float lo, float hi) { return f2bf(lo) | (f2bf(hi) << 16); }
__device__ __forceinline__ float bf2f(unsigned v) { return __builtin_bit_cast(float, v << 16); }
__device__ __forceinline__ float gelu_tanh(float x) {
    const float u2 = x * (-1.5957691216f * LOG2E - 0.0713548163f * LOG2E * x * x);
    return x * __builtin_amdgcn_rcpf(1.0f + __builtin_amdgcn_exp2f(u2));
}
__device__ __forceinline__ float sigmoidf_(float x) { return __builtin_amdgcn_rcpf(1.0f + __builtin_amdgcn_exp2f(-LOG2E * x)); }

namespace pg8 {
#define PG8_LAS __attribute__((address_space(3)))
constexpr int BM = 256, BK = 64, HALF = 128, HTB = HALF * BK * 2, STAGE_BYTES = 8 * HTB, NXCD = 8, WGM = 8;

__host__ __device__ __forceinline__ int lds_byte(int r, int c) { const int st = (r >> 4) * 2 + (c >> 5), rr = r & 15, cc = c & 31, ob = rr * 64 + cc * 2; return st * 1024 + (ob ^ (((ob >> 9) & 1) << 5)); }
__host__ __device__ __forceinline__ void stage_rc(int b, int& R, int& C) { const int st = b / 1024, sb = b % 1024, swz = sb ^ (((sb >> 9) & 1) << 5); R = (st >> 1) * 16 + swz / 64; C = (st & 1) * 32 + (swz % 64) / 2; }
__host__ __device__ __forceinline__ int perm32(int rho) { const int n = rho >> 4, i = rho & 15; return 8 * (i >> 2) + 4 * n + (i & 3); }

struct Unit { int pm, pn; };
struct Gemm { const bf16_t* A; const bf16_t* Bt; size_t bhalf; int M, N, K, pad; };

struct StaticOrder {
    int nM, nN, nwg, G, c;
    __host__ __device__ void init(int M, int N, int G_, int c_) { nM = M / BM; nN = N / BM; nwg = nM * nN; G = G_; c = c_; }
    __host__ __device__ bool next(int i, Unit& u) const {
        const long L = (long)i * G + c; if (L >= nwg) return false;
        int wgid = (int)L; { const int q = nwg / NXCD, r = nwg % NXCD, xcd = wgid % NXCD, off = wgid / NXCD; wgid = (xcd < r ? xcd * (q + 1) : r * (q + 1) + (xcd - r) * q) + off; }
        const int nig = WGM * nN, gid = wgid / nig, fm = gid * WGM, gsz = (nM - fm) < WGM ? (nM - fm) : WGM;
        u.pm = fm + ((wgid % nig) % gsz); u.pn = (wgid % nig) / gsz; return true;
    }
};

template <class Epi, bool ALIGN_EPI>
__device__ __forceinline__ void gemm_phase(PG8_LAS unsigned char* lds, const Gemm g, const StaticOrder& S, const Epi& E, const int tid) {
    const int wid = __builtin_amdgcn_readfirstlane(tid >> 6), lane = tid & 63, wr = wid >> 2, wc = wid & 3, fr = lane & 15, fq = lane >> 4;
    const int K = g.K, nt = K / BK;
    unsigned voffA[2], voffB[2];
#pragma unroll
    for (int i = 0; i < 2; ++i) { int R, C; stage_rc(tid * 16 + i * 8192, R, C);
        const int Ra = Epi::ASIG ? (128 * (R >> 6) + 8 * (R & 15) + ((R >> 4) & 3)) : R;
        const int Rb = (Epi::BMODE == 1) ? (64 * (R >> 5) + perm32(R & 31)) : (Epi::PERM ? ((R & ~31) + perm32(R & 31)) : R);
        voffA[i] = (unsigned)(Ra * K + C) * 2u; voffB[i] = (unsigned)(Rb * K + C) * 2u; }
    const size_t kstep = (size_t)(BK * 2);
    const size_t hstepA = Epi::ASIG ? (size_t)4 * K * 2 : (size_t)HALF * K * 2;
    const size_t hstepB = (Epi::BMODE == 1) ? (size_t)32 * K * 2 : ((Epi::BMODE == 2) ? g.bhalf : (size_t)HALF * K * 2);
    const size_t tstepA = (size_t)BM * K * 2;
    const size_t tstepB = (Epi::BMODE == 2) ? (size_t)HALF * K * 2 : (size_t)BM * K * 2;
    const unsigned ldsw = (unsigned)wid * 1024u;
    const int aoff = lds_byte(wr * 64 + fr, fq * 8), boff = lds_byte(wc * 32 + fr, fq * 8);
#define PG8_SA(b, h) (((b) * 2 + (h)) * HTB)
#define PG8_SB(b, h) ((4 + (b) * 2 + (h)) * HTB)
#define PG8_STAGE(bufoff, gbase, voff) do { _Pragma("unroll") for (int _i = 0; _i < 2; ++_i) \
        __builtin_amdgcn_global_load_lds((const unsigned*)((const char*)(gbase) + (voff)[_i]), (PG8_LAS unsigned*)(lds + (bufoff) + ldsw + _i * 8192), 16, 0, 0); } while (0)
#define PG8_LDA(dst, b, h) do { _Pragma("unroll") for (int m = 0; m < 4; ++m) _Pragma("unroll") for (int k = 0; k < 2; ++k) dst[m][k] = *(const PG8_LAS bf16x8*)(lds + PG8_SA(b, h) + aoff + m * 2048 + k * 1024); } while (0)
#define PG8_LDB(dst, b, h) do { _Pragma("unroll") for (int n = 0; n < 2; ++n) _Pragma("unroll") for (int k = 0; k < 2; ++k) dst[n][k] = *(const PG8_LAS bf16x8*)(lds + PG8_SB(b, h) + boff + n * 2048 + k * 1024); } while (0)
#define PG8_MMA(ai, bj, At, Bt) do { __builtin_amdgcn_s_setprio(1); _Pragma("unroll") for (int m = 0; m < 4; ++m) _Pragma("unroll") for (int n = 0; n < 2; ++n) _Pragma("unroll") for (int k = 0; k < 2; ++k) \
        acc[ai][bj][m][n] = __builtin_amdgcn_mfma_f32_16x16x32_bf16(Bt[n][k], At[m][k], acc[ai][bj][m][n], 0, 0, 0); __builtin_amdgcn_s_setprio(0); } while (0)
#define PG8_WAIT_V(n) asm volatile("s_waitcnt vmcnt(" #n ")" ::: "memory")
#define PG8_WAIT_L(n) asm volatile("s_waitcnt lgkmcnt(" #n ")" ::: "memory")
#define PG8_BAR __builtin_amdgcn_s_barrier()
#define PG8_SCHED __builtin_amdgcn_sched_barrier(0)
    Unit cur, nxt; int ui = 0;
    if (!S.next(0, cur)) return;
    f32x4 acc[2][2][4][2];
#pragma unroll
    for (int a = 0; a < 2; ++a)
#pragma unroll
        for (int b = 0; b < 2; ++b)
#pragma unroll
            for (int m = 0; m < 4; ++m)
#pragma unroll
                for (int n = 0; n < 2; ++n) acc[a][b][m][n] = (f32x4){0.f, 0.f, 0.f, 0.f};
    bf16x8 At[4][2], B0[2][2], B1[2][2];
    const char* cA = (const char*)g.A + (size_t)cur.pm * tstepA; const char* cB = (const char*)g.Bt + (size_t)cur.pn * tstepB;
    if constexpr (Epi::HAS_PRE) E.pre(lds, cur, ui, wid, lane);
    PG8_STAGE(PG8_SB(0, 0), cB, voffB); PG8_STAGE(PG8_SB(0, 1), cB + hstepB, voffB); PG8_STAGE(PG8_SA(0, 0), cA, voffA); PG8_STAGE(PG8_SA(0, 1), cA + hstepA, voffA);
    if (wr == 1) PG8_BAR;
    PG8_WAIT_V(2); PG8_BAR;
    PG8_STAGE(PG8_SB(1, 0), cB + kstep, voffB); PG8_STAGE(PG8_SA(1, 0), cA + kstep, voffA); PG8_STAGE(PG8_SB(1, 1), cB + hstepB + kstep, voffB);
    PG8_WAIT_V(6); PG8_BAR;
    for (;;) {
        const bool has_next = S.next(ui + 1, nxt);
        const char* nA = has_next ? (const char*)g.A + (size_t)nxt.pm * tstepA : cA; const char* nB = has_next ? (const char*)g.Bt + (size_t)nxt.pn * tstepB : cB;
        for (int t = 0; t < nt; t += 2) {
            const bool last = (t == nt - 2);
            const char* a1 = cA + (size_t)(t + 1) * kstep;
            const char* a2 = last ? nA : cA + (size_t)(t + 2) * kstep; const char* b2 = last ? nB : cB + (size_t)(t + 2) * kstep;
            const char* a3 = a2 + kstep; const char* b3 = b2 + kstep;
            PG8_LDB(B0, 0, 0); PG8_LDB(B1, 0, 1); PG8_SCHED; PG8_LDA(At, 0, 0); PG8_STAGE(PG8_SA(1, 1), a1 + hstepA, voffA);
            PG8_WAIT_V(8); PG8_WAIT_L(0); PG8_BAR; PG8_MMA(0, 0, At, B0); PG8_MMA(0, 1, At, B1); PG8_BAR; PG8_SCHED;
            PG8_LDA(At, 0, 1); PG8_STAGE(PG8_SB(0, 0), b2, voffB); PG8_STAGE(PG8_SB(0, 1), b2 + hstepB, voffB); PG8_STAGE(PG8_SA(0, 0), a2, voffA);
            PG8_WAIT_V(8); PG8_WAIT_L(0); PG8_BAR; PG8_MMA(1, 0, At, B0); PG8_MMA(1, 1, At, B1); PG8_BAR; PG8_SCHED;
            PG8_LDB(B0, 1, 0); PG8_LDB(B1, 1, 1); PG8_SCHED; PG8_LDA(At, 1, 0); PG8_STAGE(PG8_SA(0, 1), a2 + hstepA, voffA);
            PG8_WAIT_V(8); PG8_WAIT_L(0); PG8_BAR; PG8_MMA(0, 0, At, B0); PG8_MMA(0, 1, At, B1); PG8_BAR; PG8_SCHED;
            PG8_LDA(At, 1, 1); PG8_STAGE(PG8_SB(1, 0), b3, voffB); PG8_STAGE(PG8_SB(1, 1), b3 + hstepB, voffB); PG8_STAGE(PG8_SA(1, 0), a3, voffA);
            PG8_WAIT_V(8); PG8_WAIT_L(0); PG8_BAR; PG8_MMA(1, 0, At, B0); PG8_MMA(1, 1, At, B1); PG8_BAR; PG8_SCHED;
        }
        if constexpr (ALIGN_EPI) { if (wr == 0) PG8_BAR; }
        if constexpr (Epi::HAS_PRE) E.run(acc, cur, ui, lds, wr, wc, fr, fq); else E(acc, cur, wr, wc, fr, fq);
        if (!has_next) break;
#pragma unroll
        for (int a = 0; a < 2; ++a)
#pragma unroll
            for (int b = 0; b < 2; ++b)
#pragma unroll
                for (int m = 0; m < 4; ++m)
#pragma unroll
                    for (int n = 0; n < 2; ++n) acc[a][b][m][n] = (f32x4){0.f, 0.f, 0.f, 0.f};
        cur = nxt; cA = nA; cB = nB; ++ui;
        if constexpr (Epi::HAS_PRE) E.pre(lds, cur, ui, wid, lane);
        if constexpr (ALIGN_EPI) { if (wr == 1) PG8_BAR; }
    }
    PG8_WAIT_V(0);
    if constexpr (!ALIGN_EPI) { if (wr == 0) PG8_BAR; }
    PG8_BAR;
#undef PG8_SA
#undef PG8_SB
#undef PG8_STAGE
#undef PG8_LDA
#undef PG8_LDB
#undef PG8_MMA
#undef PG8_WAIT_V
#undef PG8_WAIT_L
#undef PG8_BAR
#undef PG8_SCHED
}
}

__device__ __forceinline__ unsigned cvt_pk_bf16(float lo, float hi) { unsigned r; asm volatile("v_cvt_pk_bf16_f32 %0, %1, %2" : "=v"(r) : "v"(lo), "v"(hi)); return r; }
constexpr int SPARE_RS = 131072 + 1024, SPARE_CW = SPARE_RS + 2048, SPARE_ST = SPARE_CW + 4096, ST_ROW = 144, ST_WAVE = 16 * ST_ROW;
static_assert(SPARE_ST + 8 * ST_WAVE <= 163840, "LDS map");
__device__ __forceinline__ void st_rows_to_lane16(PG8_LAS unsigned char* wb, u32x4 r0, u32x4 r1, int fr, int fq, int rt, int ct, u32x4& p0, u32x4& p1) {
    *(PG8_LAS u32x4*)(wb + rt * ST_ROW + ct * 16) = r0; *(PG8_LAS u32x4*)(wb + (rt + 8) * ST_ROW + ct * 16) = r1;
    p0 = *(const PG8_LAS u32x4*)(wb + fr * ST_ROW + fq * 16); p1 = *(const PG8_LAS u32x4*)(wb + fr * ST_ROW + 64 + fq * 16);
}
__device__ __forceinline__ void st_lane16_to_rows(PG8_LAS unsigned char* wb, u32x4 p0, u32x4 p1, int fr, int fq, int rt, int ct, u32x4& r0, u32x4& r1) {
    *(PG8_LAS u32x4*)(wb + fr * ST_ROW + fq * 16) = p0; *(PG8_LAS u32x4*)(wb + fr * ST_ROW + 64 + fq * 16) = p1;
    r0 = *(const PG8_LAS u32x4*)(wb + rt * ST_ROW + ct * 16); r1 = *(const PG8_LAS u32x4*)(wb + (rt + 8) * ST_ROW + ct * 16);
}
__device__ __forceinline__ void st_rows_to_lane32(PG8_LAS unsigned char* wb, u32x4 r0, u32x4 r1, int fr, int fq, int rt, int ct, u32x4& p0, u32x4& p1) {
    *(PG8_LAS u32x4*)(wb + rt * ST_ROW + ct * 16) = r0; *(PG8_LAS u32x4*)(wb + (rt + 8) * ST_ROW + ct * 16) = r1;
    p0 = *(const PG8_LAS u32x4*)(wb + fr * ST_ROW + fq * 32); p1 = *(const PG8_LAS u32x4*)(wb + fr * ST_ROW + fq * 32 + 16);
}

struct EpiInProj {
    static constexpr bool PERM = true, ASIG = false, HAS_PRE = true; static constexpr int BMODE = 1;
    __device__ __forceinline__ void pre(PG8_LAS unsigned char*, const pg8::Unit&, int, int, int) const {}
    bf16_t* base; const float* qg; const float* kg; float* KM;
    __device__ __forceinline__ void run(const f32x4 (&acc)[2][2][4][2], const pg8::Unit& u, int ui, PG8_LAS unsigned char* lds, int wr, int wc, int fr, int fq) const {
        const int lane = fr + 16 * fq, rt = lane >> 3, ct = lane & 7; PG8_LAS unsigned char* wb = lds + SPARE_ST + (wr * 4 + wc) * ST_WAVE;
        const int gc0 = u.pn * 256, seg = gc0 >> 9;
        bf16_t* O = base + (size_t)seg * ((size_t)SEQ * 512) + (gc0 & 511) + 64 * wc + ct * 8;
        const int row0 = u.pm * 256 + wr * 64 + rt;
        if (seg == 2 || seg == 3) {
            const float* gp = (seg == 2) ? qg : kg; const float sc = (seg == 2) ? C2 : 1.0f;
            f32x4 gv[2][2], cs[2][2];
#pragma unroll
            for (int bj = 0; bj < 2; ++bj)
#pragma unroll
                for (int n = 0; n < 2; ++n) { gv[bj][n] = *(const f32x4*)(gp + 32 * bj + 8 * fq + 4 * n) * sc; cs[bj][n] = (f32x4){0.f, 0.f, 0.f, 0.f}; }
#pragma unroll
            for (int ai = 0; ai < 2; ++ai)
#pragma unroll
                for (int m = 0; m < 4; ++m) {
                    float ss = 0.f;
#pragma unroll
                    for (int bj = 0; bj < 2; ++bj)
#pragma unroll
                        for (int n = 0; n < 2; ++n) { const f32x4 x = acc[ai][bj][m][n]; ss += (x[0] * x[0] + x[1] * x[1]) + (x[2] * x[2] + x[3] * x[3]); }
                    ss += __shfl_xor(ss, 16); ss += __shfl_xor(ss, 32);
                    const float rstd = rsqrtf(ss * (1.0f / 64.0f) + EPS);
                    bf16_t* rowp = O + (size_t)(row0 + ai * 128 + m * 16) * 512; u32x4 w[2];
#pragma unroll
                    for (int bj = 0; bj < 2; ++bj) { const f32x4 v0 = acc[ai][bj][m][0] * rstd * gv[bj][0], v1 = acc[ai][bj][m][1] * rstd * gv[bj][1];
                        cs[bj][0] += v0; cs[bj][1] += v1;
                        w[bj].x = cvt_pk_bf16(v0[0], v0[1]); w[bj].y = cvt_pk_bf16(v0[2], v0[3]); w[bj].z = cvt_pk_bf16(v1[0], v1[1]); w[bj].w = cvt_pk_bf16(v1[2], v1[3]); }
                    u32x4 r0, r1; st_lane16_to_rows(wb, w[0], w[1], fr, fq, rt, ct, r0, r1); *(u32x4*)rowp = r0; *(u32x4*)(rowp + 8 * 512) = r1;
                }
            if (seg == 3) {
                float* kmp = KM + ((size_t)((u.pm >> 4) * NH + (u.pn & 1) * 4 + wc) * 16 + (u.pm & 15)) * 64 + 8 * fq;
#pragma unroll
                for (int bj = 0; bj < 2; ++bj)
#pragma unroll
                    for (int n = 0; n < 2; ++n)
#pragma unroll
                        for (int e = 0; e < 4; ++e) { float s = cs[bj][n][e]; s += __shfl_xor(s, 1); s += __shfl_xor(s, 2); s += __shfl_xor(s, 4); s += __shfl_xor(s, 8);
                            if (fr == 0) atomicAdd(kmp + 32 * bj + 4 * n + e, s * (1.0f / 256.0f)); }
            }
        } else {
#pragma unroll
            for (int ai = 0; ai < 2; ++ai)
#pragma unroll
                for (int m = 0; m < 4; ++m) { bf16_t* rowp = O + (size_t)(row0 + ai * 128 + m * 16) * 512; u32x4 w[2];
#pragma unroll
                    for (int bj = 0; bj < 2; ++bj) { const f32x4 v0 = acc[ai][bj][m][0], v1 = acc[ai][bj][m][1];
                        w[bj].x = cvt_pk_bf16(v0[0], v0[1]); w[bj].y = cvt_pk_bf16(v0[2], v0[3]); w[bj].z = cvt_pk_bf16(v1[0], v1[1]); w[bj].w = cvt_pk_bf16(v1[2], v1[3]); }
                    u32x4 r0, r1; st_lane16_to_rows(wb, w[0], w[1], fr, fq, rt, ct, r0, r1); *(u32x4*)rowp = r0; *(u32x4*)(rowp + 8 * 512) = r1; }
        }
    }
};
#define NT_LD(p) __builtin_nontemporal_load((const u32x4*)(p))
#define NT_ST(p, v) __builtin_nontemporal_store((v), (u32x4*)(p))
struct EpiBf16Plain {
    static constexpr bool PERM = true, ASIG = false, HAS_PRE = true; static constexpr int BMODE = 1;
    bf16_t* O; long pad_;
    static constexpr int ldc = DM;
    __device__ __forceinline__ void pre(PG8_LAS unsigned char*, const pg8::Unit&, int, int, int) const {}
    __device__ __forceinline__ void run(const f32x4 (&acc)[2][2][4][2], const pg8::Unit& u, int ui, PG8_LAS unsigned char* lds, int wr, int wc, int fr, int fq) const {
        int lane; asm volatile("v_mbcnt_lo_u32_b32 %0, -1, 0\n\tv_mbcnt_hi_u32_b32 %0, -1, %0" : "=&v"(lane));
        const int rt = lane >> 3, ct = lane & 7; PG8_LAS unsigned char* wb = lds + SPARE_ST + (wr * 4 + wc) * ST_WAVE;
        const int ob = (u.pm * 256 + wr * 64 + rt) * ldc + u.pn * 256 + 64 * wc + ct * 8;
#pragma unroll
        for (int ai = 0; ai < 2; ++ai)
#pragma unroll
            for (int m = 0; m < 4; ++m) { u32x4 w[2];
#pragma unroll
                for (int bj = 0; bj < 2; ++bj) { const f32x4 v0 = acc[ai][bj][m][0], v1 = acc[ai][bj][m][1];
                    w[bj].x = cvt_pk_bf16(v0[0], v0[1]); w[bj].y = cvt_pk_bf16(v0[2], v0[3]); w[bj].z = cvt_pk_bf16(v1[0], v1[1]); w[bj].w = cvt_pk_bf16(v1[2], v1[3]); }
                u32x4 r0, r1; st_lane16_to_rows(wb, w[0], w[1], fr, fq, rt, ct, r0, r1);
                bf16_t* rowp = O + (ob + (ai * 128 + m * 16) * ldc); NT_ST(rowp, r0); NT_ST(rowp + 8 * ldc, r1); }
    }
};
template <int BASE> struct EpiResid {
    static constexpr bool PERM = true, ASIG = false, HAS_PRE = true, BASE_BF16 = (BASE != 0); static constexpr int BMODE = 1;
    const void* basev; bf16_t* xb; float* ss; const float* rinv; const float* gmix;
    __device__ __forceinline__ void pre(PG8_LAS unsigned char*, const pg8::Unit&, int, int, int) const {}
    __device__ __forceinline__ void run(const f32x4 (&acc)[2][2][4][2], const pg8::Unit& u, int ui, PG8_LAS unsigned char* lds, int wr, int wc, int fr, int fq) const {
        const int lane = fr + 16 * fq, rt = lane >> 3, ct = lane & 7;
        PG8_LAS unsigned char* wb = lds + SPARE_ST + (wr * 4 + wc) * ST_WAVE;
        const int rows0 = u.pm * 256 + wr * 64, cols0 = u.pn * 256 + 64 * wc;
        constexpr int DEPTH = BASE_BF16 ? 4 : 2, NR = BASE_BF16 ? 2 : 4;
        u32x4 X[DEPTH][NR];
#define ER_LOAD(slot, g) do { const size_t r_ = (size_t)(rows0 + ((g) >> 2) * 128 + ((g) & 3) * 16 + rt) * DM + cols0; \
        if constexpr (BASE_BF16) { X[slot][0] = NT_LD((const bf16_t*)basev + r_ + ct * 8); X[slot][1] = NT_LD((const bf16_t*)basev + r_ + 8 * DM + ct * 8); } \
        else { X[slot][0] = NT_LD((const float*)basev + r_ + ct * 4); X[slot][1] = NT_LD((const float*)basev + r_ + 8 * DM + ct * 4); \
               X[slot][2] = NT_LD((const float*)basev + r_ + 32 + ct * 4); X[slot][3] = NT_LD((const float*)basev + r_ + 8 * DM + 32 + ct * 4); } } while (0)
#pragma unroll
        for (int g = 0; g < DEPTH; ++g) ER_LOAD(g, g);
        float ri[8]; f32x4 gi[2][2];
        if constexpr (BASE == 2) {
#pragma unroll
            for (int g = 0; g < 8; ++g) ri[g] = rinv[rows0 + (g >> 2) * 128 + (g & 3) * 16 + fr];
#pragma unroll
            for (int bj = 0; bj < 2; ++bj)
#pragma unroll
                for (int n = 0; n < 2; ++n) { const f32x4 gg = *(const f32x4*)(gmix + cols0 + 32 * bj + 8 * fq + 4 * n);
                    gi[bj][n] = (f32x4){__builtin_amdgcn_rcpf(gg[0]), __builtin_amdgcn_rcpf(gg[1]), __builtin_amdgcn_rcpf(gg[2]), __builtin_amdgcn_rcpf(gg[3])}; } }
#pragma unroll
        for (int g = 0; g < 8; ++g) { const int ai = g >> 2, m = g & 3; float s = 0.f;
            f32x4 bs[2][2];
            if constexpr (BASE_BF16) { u32x4 p0, p1; st_rows_to_lane16(wb, X[g % DEPTH][0], X[g % DEPTH][1], fr, fq, rt, ct, p0, p1);
                bs[0][0] = (f32x4){bf2f(p0.x & 0xffffu), bf2f(p0.x >> 16), bf2f(p0.y & 0xffffu), bf2f(p0.y >> 16)}; bs[0][1] = (f32x4){bf2f(p0.z & 0xffffu), bf2f(p0.z >> 16), bf2f(p0.w & 0xffffu), bf2f(p0.w >> 16)};
                bs[1][0] = (f32x4){bf2f(p1.x & 0xffffu), bf2f(p1.x >> 16), bf2f(p1.y & 0xffffu), bf2f(p1.y >> 16)}; bs[1][1] = (f32x4){bf2f(p1.z & 0xffffu), bf2f(p1.z >> 16), bf2f(p1.w & 0xffffu), bf2f(p1.w >> 16)}; }
            else {
#pragma unroll
                for (int bj = 0; bj < 2; ++bj) { u32x4 p0, p1; st_rows_to_lane32(wb, X[g % DEPTH][2 * bj], X[g % DEPTH][2 * bj + 1], fr, fq, rt, ct, p0, p1);
                    bs[bj][0] = __builtin_bit_cast(f32x4, p0); bs[bj][1] = __builtin_bit_cast(f32x4, p1); } }
            if (g + DEPTH < 8) ER_LOAD(g % DEPTH, g + DEPTH);
            if constexpr (BASE == 2) {
#pragma unroll
                for (int bj = 0; bj < 2; ++bj)
#pragma unroll
                    for (int n = 0; n < 2; ++n) bs[bj][n] = bs[bj][n] * gi[bj][n] * ri[g]; }
            u32x4 pc[2];
#pragma unroll
            for (int bj = 0; bj < 2; ++bj) { const f32x4 o0 = bs[bj][0] + acc[ai][bj][m][0], o1 = bs[bj][1] + acc[ai][bj][m][1];
                s += ((o0[0] * o0[0] + o0[1] * o0[1]) + (o0[2] * o0[2] + o0[3] * o0[3])) + ((o1[0] * o1[0] + o1[1] * o1[1]) + (o1[2] * o1[2] + o1[3] * o1[3]));
                pc[bj].x = cvt_pk_bf16(o0[0], o0[1]); pc[bj].y = cvt_pk_bf16(o0[2], o0[3]); pc[bj].z = cvt_pk_bf16(o1[0], o1[1]); pc[bj].w = cvt_pk_bf16(o1[2], o1[3]); }
            u32x4 r0, r1; st_lane16_to_rows(wb, pc[0], pc[1], fr, fq, rt, ct, r0, r1);
            bf16_t* op = xb + (size_t)(rows0 + ai * 128 + m * 16 + rt) * DM + cols0 + ct * 8;
            *(u32x4*)op = r0; *(u32x4*)(op + 8 * DM) = r1;
            s += __shfl_xor(s, 16); s += __shfl_xor(s, 32);
            if (fq == 0) ss[(size_t)(rows0 + ai * 128 + m * 16 + fr) * 16 + u.pn * 4 + wc] = s; }
#undef ER_LOAD
    }
};
__device__ __forceinline__ f32x4 ss_part(const float* ss, int row, int fq) { return *(const f32x4*)(ss + (size_t)row * 16 + 4 * fq); }
__device__ __forceinline__ float rstd_from(f32x4 p) { float s = (p[0] + p[1]) + (p[2] + p[3]); s += __shfl_xor(s, 16); s += __shfl_xor(s, 32); return rsqrtf(s * (1.0f / DM) + EPS); }
__device__ __forceinline__ float row_rstd(const float* ss, int row, int fq) {
    const f32x4 p = *(const f32x4*)(ss + (size_t)row * 16 + 4 * fq); float s = (p[0] + p[1]) + (p[2] + p[3]);
    s += __shfl_xor(s, 16); s += __shfl_xor(s, 32); return rsqrtf(s * (1.0f / DM) + EPS);
}
__device__ __forceinline__ float dpp_shr1(float old, float v) { return __builtin_bit_cast(float, __builtin_amdgcn_update_dpp(__builtin_bit_cast(int, old), __builtin_bit_cast(int, v), 0x111, 0xf, 0xf, false)); }
__device__ __forceinline__ float dpp_ror1(float v) { return __builtin_bit_cast(float, __builtin_amdgcn_update_dpp(__builtin_bit_cast(int, v), __builtin_bit_cast(int, v), 0x121, 0xf, 0xf, false)); }
struct EpiUpFused {
    static constexpr bool PERM = true, ASIG = true, HAS_PRE = true; static constexpr int BMODE = 2;
    bf16_t* ACT; const float* cw; const float* cb; float* GT; float* PART; float* VH; const float* ssg; int pm0, pm1;
    __device__ __forceinline__ void pre(PG8_LAS unsigned char* lds, const pg8::Unit& u, int ui, int wid, int lane) const {
        if (wid < 2) { const int idx = 4 * (64 * wid + lane), arr = idx >> 7, col = idx & 127; const float* src_ = (arr < 3 ? cw + (size_t)arr * DFF : cb) + u.pn * 128 + col;
            __builtin_amdgcn_global_load_lds((const unsigned*)src_, (PG8_LAS unsigned*)(lds + SPARE_CW + (ui & 1) * 2048 + wid * 1024), 16, 0, 0); }
    }
    __device__ __forceinline__ void run(const f32x4 (&acc)[2][2][4][2], const pg8::Unit& u, int ui, PG8_LAS unsigned char* lds, int wr, int wc, int fr, int fq) const {
        const int j0 = u.pn * 128 + wc * 32 + 8 * fq, rbase = u.pm * 256 + 128 * wr + 8 * fr, strip = u.pm * 2 + wr;
        float rs[8];
        if (pm1 >= 0) { const PG8_LAS f32x4* rp = (const PG8_LAS f32x4*)(lds + SPARE_RS + (u.pm == pm0 ? 0 : 1024) + (128 * wr + 8 * fr) * 4); const f32x4 r0 = rp[0], r1 = rp[1];
          rs[0] = r0[0]; rs[1] = r0[1]; rs[2] = r0[2]; rs[3] = r0[3]; rs[4] = r1[0]; rs[5] = r1[1]; rs[6] = r1[2]; rs[7] = r1[3]; }
        else {
#pragma unroll
            for (int s = 0; s < 8; ++s) rs[s] = rstd_from(ss_part(ssg, rbase + s, fq)); }
        f32x2 w0[4], w1[4], w2[4], bb[4], pm1[4], pm2[4];
        { const PG8_LAS f32x4* wp = (const PG8_LAS f32x4*)(lds + SPARE_CW + (ui & 1) * 2048 + (wc * 32 + 8 * fq) * 4);
          const f32x4 a0 = wp[0], a1 = wp[1], b0 = wp[32], b1 = wp[33], c0 = wp[64], c1 = wp[65], d0 = wp[96], d1 = wp[97];
          w0[0] = (f32x2){a0[0], a0[1]}; w0[1] = (f32x2){a0[2], a0[3]}; w0[2] = (f32x2){a1[0], a1[1]}; w0[3] = (f32x2){a1[2], a1[3]};
          w1[0] = (f32x2){b0[0], b0[1]}; w1[1] = (f32x2){b0[2], b0[3]}; w1[2] = (f32x2){b1[0], b1[1]}; w1[3] = (f32x2){b1[2], b1[3]};
          w2[0] = (f32x2){c0[0], c0[1]}; w2[1] = (f32x2){c0[2], c0[3]}; w2[2] = (f32x2){c1[0], c1[1]}; w2[3] = (f32x2){c1[2], c1[3]};
          bb[0] = (f32x2){d0[0], d0[1]}; bb[1] = (f32x2){d0[2], d0[3]}; bb[2] = (f32x2){d1[0], d1[1]}; bb[3] = (f32x2){d1[2], d1[3]}; }
#pragma unroll
        for (int q = 0; q < 4; ++q) { const int n = q >> 1, h = q & 1;
            const f32x2 g6 = (f32x2){acc[1][0][2][n][2 * h], acc[1][0][2][n][2 * h + 1]} * rs[6], g7 = (f32x2){acc[1][0][3][n][2 * h], acc[1][0][3][n][2 * h + 1]} * rs[7];
            pm2[q].x = dpp_shr1(0.f, g6.x); pm2[q].y = dpp_shr1(0.f, g6.y); pm1[q].x = dpp_shr1(0.f, g7.x); pm1[q].y = dpp_shr1(0.f, g7.y); }
#pragma unroll
        for (int s = 0; s < 8; ++s) { const int ai = s >> 2, m = s & 3, row = rbase + s; const float rstd = rs[s];
            f32x2 a[4];
#pragma unroll
            for (int q = 0; q < 4; ++q) { const int n = q >> 1, h = q & 1;
                const f32x2 g = (f32x2){acc[ai][0][m][n][2 * h], acc[ai][0][m][n][2 * h + 1]} * rstd, v = (f32x2){acc[ai][1][m][n][2 * h], acc[ai][1][m][n][2 * h + 1]} * rstd;
                const f32x2 pre = w0[q] * pm2[q] + (w1[q] * pm1[q] + (w2[q] * g + bb[q]));
                pm2[q] = pm1[q]; pm1[q] = g;
                const f32x2 t = pre * pre, uu = t * (-0.0713548163f * LOG2E) + (-1.5957691216f * LOG2E), z = pre * uu;
                f32x2 ee; ee.x = __builtin_amdgcn_exp2f(z.x); ee.y = __builtin_amdgcn_exp2f(z.y);
                const f32x2 dd = ee + 1.0f; f32x2 rr; rr.x = __builtin_amdgcn_rcpf(dd.x); rr.y = __builtin_amdgcn_rcpf(dd.y);
                a[q] = (pre * rr) * v;
                if (s < 2 && fr == 0) { *(f32x2*)(PART + ((size_t)strip * 2 + s) * DFF + j0 + 2 * q) = pre; *(f32x2*)(VH + ((size_t)strip * 2 + s) * DFF + j0 + 2 * q) = v; }
                if (s >= 6 && fr == 15) *(f32x2*)(GT + ((size_t)strip * 2 + (s - 6)) * DFF + j0 + 2 * q) = g; }
            u32x4 w; w.x = cvt_pk_bf16(a[0].x, a[0].y); w.y = cvt_pk_bf16(a[1].x, a[1].y); w.z = cvt_pk_bf16(a[2].x, a[2].y); w.w = cvt_pk_bf16(a[3].x, a[3].y);
            *(u32x4*)(ACT + (size_t)row * DFF + j0) = w; }
    }
};
struct EpiFinal {
    static constexpr bool PERM = true, ASIG = false, HAS_PRE = true; static constexpr int BMODE = 1;
    float* out; const bf16_t* h2b; const bf16_t* prj; const float* ss;
    __device__ __forceinline__ void pre(PG8_LAS unsigned char*, const pg8::Unit&, int, int, int) const {}
    __device__ __forceinline__ void run(const f32x4 (&acc)[2][2][4][2], const pg8::Unit& u, int ui, PG8_LAS unsigned char* lds, int wr, int wc, int fr, int fq) const {
        const int lane = fr + 16 * fq, rt = lane >> 3, ct = lane & 7;
        PG8_LAS unsigned char* wb = lds + SPARE_ST + (wr * 4 + wc) * ST_WAVE;
        const int rows0 = u.pm * 256 + wr * 64, cols0 = u.pn * 256 + 64 * wc;
        float rs[8];
        { f32x4 sp[8];
#pragma unroll
          for (int g = 0; g < 8; ++g) sp[g] = ss_part(ss, rows0 + (g >> 2) * 128 + (g & 3) * 16 + fr, fq);
#pragma unroll
          for (int g = 0; g < 8; ++g) rs[g] = rstd_from(sp[g]); }
        constexpr int DEPTH = 3;
        u32x4 H[DEPTH][2], P[DEPTH][2];
#define EF_LOAD(slot, g) do { const size_t o_ = (size_t)(rows0 + ((g) >> 2) * 128 + ((g) & 3) * 16 + rt) * DM + cols0 + ct * 8; \
        H[slot][0] = NT_LD(h2b + o_); H[slot][1] = NT_LD(h2b + o_ + 8 * DM); P[slot][0] = NT_LD(prj + o_); P[slot][1] = NT_LD(prj + o_ + 8 * DM); } while (0)
#pragma unroll
        for (int g = 0; g < DEPTH; ++g) EF_LOAD(g, g);
#pragma unroll
        for (int g = 0; g < 8; ++g) { const int ai = g >> 2, m = g & 3; const float rstd = rs[g];
            u32x4 hv[2], pv[2];
            *(PG8_LAS u32x4*)(wb + rt * ST_ROW + ct * 16) = H[g % DEPTH][0]; *(PG8_LAS u32x4*)(wb + (rt + 8) * ST_ROW + ct * 16) = H[g % DEPTH][1];
            hv[0] = *(const PG8_LAS u32x4*)(wb + fr * ST_ROW + fq * 16); hv[1] = *(const PG8_LAS u32x4*)(wb + fr * ST_ROW + 64 + fq * 16);
            *(PG8_LAS u32x4*)(wb + rt * ST_ROW + ct * 16) = P[g % DEPTH][0]; *(PG8_LAS u32x4*)(wb + (rt + 8) * ST_ROW + ct * 16) = P[g % DEPTH][1];
            pv[0] = *(const PG8_LAS u32x4*)(wb + fr * ST_ROW + fq * 16); pv[1] = *(const PG8_LAS u32x4*)(wb + fr * ST_ROW + 64 + fq * 16);
            if (g + DEPTH < 8) EF_LOAD(g % DEPTH, g + DEPTH);
#pragma unroll
            for (int bj = 0; bj < 2; ++bj) { f32x4 o[2];
#pragma unroll
                for (int n = 0; n < 2; ++n) { const f32x4 a = acc[ai][bj][m][n] * rstd; const unsigned h0 = hv[bj][2 * n], h1 = hv[bj][2 * n + 1], p0 = pv[bj][2 * n], p1 = pv[bj][2 * n + 1];
                    o[n][0] = bf2f(h0 & 0xffffu) + sigmoidf_(a[0]) * bf2f(p0 & 0xffffu); o[n][1] = bf2f(h0 >> 16) + sigmoidf_(a[1]) * bf2f(p0 >> 16);
                    o[n][2] = bf2f(h1 & 0xffffu) + sigmoidf_(a[2]) * bf2f(p1 & 0xffffu); o[n][3] = bf2f(h1 >> 16) + sigmoidf_(a[3]) * bf2f(p1 >> 16); }
                *(PG8_LAS u32x4*)(wb + fr * ST_ROW + fq * 32) = __builtin_bit_cast(u32x4, o[0]); *(PG8_LAS u32x4*)(wb + fr * ST_ROW + fq * 32 + 16) = __builtin_bit_cast(u32x4, o[1]);
                const u32x4 r0 = *(const PG8_LAS u32x4*)(wb + rt * ST_ROW + ct * 16), r1 = *(const PG8_LAS u32x4*)(wb + (rt + 8) * ST_ROW + ct * 16);
                float* op = out + (size_t)(rows0 + ai * 128 + m * 16 + rt) * DM + cols0 + 32 * bj + ct * 4;
                NT_ST(op, r0); NT_ST(op + 8 * DM, r1); } }
#undef EF_LOAD
    }
};

#define GAS __attribute__((address_space(1)))
#define LAS __attribute__((address_space(3)))
typedef float f32x16 __attribute__((ext_vector_type(16)));
#define LDS_WAIT() asm volatile("s_waitcnt lgkmcnt(0)" ::: "memory")
#define VM_WAIT() asm volatile("s_waitcnt vmcnt(0)" ::: "memory")
constexpr int NWAVES = 8;
constexpr int RING_BYTES = 131072, MISC_OFF = RING_BYTES + 320, LDS_BYTES = 163840;

#define XB_TMO      128
#define XB_XCNT(j)  (256  + 64 * (j))
#define XB_XSUB(j)  (1280 + 64 * (j))
#define XB_XGEN(j)  (2304 + 64 * (j))
#define XB_TOP      3328
#define XB_TOPGEN   3392
#define XCD_BAR_WORDS 3456
#define XB_SPIN_CAP (1u << 20)
__device__ __forceinline__ unsigned xb_ld(unsigned* p)              { return __hip_atomic_load(p, __ATOMIC_RELAXED, __HIP_MEMORY_SCOPE_AGENT); }
__device__ __forceinline__ unsigned xb_add(unsigned* p, unsigned v) { return __hip_atomic_fetch_add(p, v, __ATOMIC_RELAXED, __HIP_MEMORY_SCOPE_AGENT); }
__device__ __forceinline__ unsigned xb_xcc_id() { return (unsigned)__builtin_amdgcn_s_getreg((3 << 11) | 20) & 0xFu; }
#define XB_SPIN(cond, bar) do { unsigned _sp = 0; while (cond) { __builtin_amdgcn_s_sleep(1); \
    if ((++_sp & 255u) == 0u) { if (xb_ld(&(bar)[XB_TMO])) break; if (_sp > XB_SPIN_CAP) { atomicAdd(&(bar)[XB_TMO], 1u); break; } } } } while (0)
struct XcdBarrier { unsigned* bar; unsigned x; volatile LAS unsigned* st; };
__device__ __forceinline__ XcdBarrier xcd_barrier_post(unsigned* bar, volatile LAS unsigned* st) {
    XcdBarrier b; b.bar = bar; b.x = xb_xcc_id(); b.st = st;
    if (threadIdx.x == 0) { (void)xb_add(&bar[XB_XCNT(b.x)], 1u); __hip_atomic_store(&bar[10240   + blockIdx.x], b.x + 1u, __ATOMIC_RELAXED, __HIP_MEMORY_SCOPE_AGENT); }
    return b;
}
__device__ __forceinline__ void xcd_barrier_complete(unsigned* bar, unsigned x, unsigned& nloc, unsigned& nx) {
    const unsigned G = gridDim.x * gridDim.y * gridDim.z;
    unsigned sum, cnt, mine, sp = 0u;
    for (;;) {
        sum = 0u; cnt = 0u; mine = 0u;
#pragma unroll
        for (unsigned j = 0; j < 16; ++j) { const unsigned c = xb_ld(&bar[XB_XCNT(j)]); sum += c; cnt += (c > 0u) ? 1u : 0u; mine = (j == x) ? c : mine; }
        if (sum == G) break;
        __builtin_amdgcn_s_sleep(1);
        if ((++sp & 255u) == 0u) { if (xb_ld(&bar[XB_TMO])) break; if (sp > XB_SPIN_CAP) { atomicAdd(&bar[XB_TMO], 1u); break; } }
    }
    nloc = mine > 0u ? mine : 1u; nx = cnt > 0u ? cnt : 1u;
}
__device__ __forceinline__ void xcd_barrier(const XcdBarrier& b) {
    asm volatile("s_waitcnt vmcnt(0)" ::: "memory");
    __syncthreads();
    if (threadIdx.x == 0) {
        unsigned* bar = b.bar;
        __builtin_amdgcn_s_waitcnt(0);
        unsigned nloc = b.st[0], nx = b.st[1];
        if (nloc == 0u) { xcd_barrier_complete(bar, b.x, nloc, nx); b.st[0] = nloc; b.st[1] = nx; }
        const unsigned old = xb_add(&bar[XB_XSUB(b.x)], 1u);
        const unsigned gen = old / nloc;
        if (old + 1u == (gen + 1u) * nloc) {
            __builtin_amdgcn_fence(__ATOMIC_RELEASE, "agent");
            asm volatile("s_waitcnt vmcnt(0)" ::: "memory");
            const unsigned og = xb_add(&bar[XB_TOP], 1u);
            const unsigned tg = og / nx;
            if (og + 1u == (tg + 1u) * nx) xb_add(&bar[XB_TOPGEN], 1u);
            else XB_SPIN(xb_ld(&bar[XB_TOPGEN]) == tg, bar);
            __builtin_amdgcn_fence(__ATOMIC_ACQUIRE, "agent");
            xb_add(&bar[XB_XGEN(b.x)], 1u);
            asm volatile("s_waitcnt vmcnt(0)" ::: "memory");
        } else {
            XB_SPIN(xb_ld(&bar[XB_XGEN(b.x)]) == gen, bar);
            __builtin_amdgcn_fence(__ATOMIC_ACQUIRE, "agent");
            asm volatile("s_waitcnt vmcnt(0)" ::: "memory");
        }
    }
    __syncthreads();
}

#define GB_SUB(r) (9216 + 64 * (r))
#define GB_GEN(r) (9728 + 64 * (r))
#define GB_XID    10240
#define GB_WCNT   10752
struct GrpBarV { unsigned* bar; unsigned r, n, fast; };
__device__ __forceinline__ void grp_barrier(unsigned* bar_, volatile LAS unsigned* fastp, const bool inv) {
    asm volatile("s_waitcnt vmcnt(0)" ::: "memory");
    __syncthreads();
    if (threadIdx.x == 0) {
        GrpBarV g{bar_, blockIdx.x & 7u, gridDim.x >> 3, *fastp};
        unsigned* bar = g.bar;
        if (g.fast == 0u) {
            const unsigned me = xb_ld(&bar[GB_XID + blockIdx.x]); bool ok = (me != 0u);
            for (unsigned i = g.r; i < gridDim.x; i += 8u) ok = ok && (xb_ld(&bar[GB_XID + i]) == me);
            g.fast = ok ? 1u : 2u; *fastp = g.fast; }
        if (g.fast != 1u) { __builtin_amdgcn_fence(__ATOMIC_RELEASE, "agent"); asm volatile("s_waitcnt vmcnt(0)" ::: "memory"); }
        const unsigned old = xb_add(&bar[GB_SUB(g.r)], 1u);
        const unsigned gen = old / g.n;
        if (old + 1u == (gen + 1u) * g.n) __hip_atomic_store(&bar[GB_GEN(g.r)], gen + 1u, __ATOMIC_RELAXED, __HIP_MEMORY_SCOPE_AGENT);
        else XB_SPIN(xb_ld(&bar[GB_GEN(g.r)]) <= gen, bar);
        if (g.fast != 1u || inv) { __builtin_amdgcn_fence(__ATOMIC_ACQUIRE, "agent");
        asm volatile("s_waitcnt vmcnt(0)" ::: "memory"); }
    }
    __syncthreads();
}

constexpr size_t MiB = 1u << 20;
constexpr size_t WS_CTL = 0, CTL_ZERO_BYTES = 64 * 1024;
constexpr size_t WS_RINV0 = 6 * MiB + 512 * 1024;
constexpr size_t WS_KM = 1 * MiB, WS_SS1 = 2 * MiB, WS_SS2 = 4 * MiB, WS_GW = 6 * MiB  , WS_SUMM = 7 * MiB  ;
constexpr size_t WS_WIN = 8 * MiB, WS_WOUT = 13 * MiB, WS_WUP = 15 * MiB, WS_WDN = 27 * MiB, WS_WG = 33 * MiB, WS_WP = 35 * MiB;
constexpr size_t WS_XN = 40 * MiB;
constexpr size_t WS_PB = 104 * MiB;
constexpr size_t WS_PRJ = 120 * MiB;
constexpr size_t WS_R = 184 * MiB, SLAB = 32 * MiB;
constexpr size_t WS_GT = 480 * MiB, WS_PART = 488 * MiB, WS_VH = 496 * MiB;
constexpr size_t WS_END = 512 * MiB;

struct Args { const float* in[22]; float* out; unsigned char* ws; int ph_lo, ph_hi; };
struct Frame {
    LAS unsigned char* lds; int tid, lane, wave, vcu, G;
};
__device__ __forceinline__ float wave_sum(float v) {
#pragma unroll
    for (int o = 1; o < 64; o <<= 1) v += __shfl_xor(v, o);
    return v;
}
__device__ __forceinline__ float wave_max(float v) {
#pragma unroll
    for (int o = 1; o < 64; o <<= 1) v = fmaxf(v, __shfl_xor(v, o));
    return v;
}
__device__ __forceinline__ void p0_transpose_item(const float* W, int ldw, int N, bf16_t* WT, int ldt, const float* gain, LAS float* scr, int item, int lane) {
    const int nblk = N / 32, kb = item / nblk, nb = item % nblk, k0 = 64 * kb, n0 = 32 * nb;
#pragma unroll
    for (int i = 0; i < 32; ++i) { const int kk = 2 * i + (lane >> 5); scr[kk * 33 + (lane & 31)] = __builtin_nontemporal_load(W + (size_t)(k0 + kk) * ldw + n0 + (lane & 31)) * (gain ? gain[k0 + kk] : 1.0f); }
    LDS_WAIT(); asm volatile("" ::: "memory");
    const int c = lane & 7;
#pragma unroll
    for (int j = 0; j < 4; ++j) { const int n = (lane >> 3) + 8 * j; const LAS float* s = scr + (8 * c) * 33 + n;
        u32x4 o; o.x = pk2(s[0 * 33], s[1 * 33]); o.y = pk2(s[2 * 33], s[3 * 33]); o.z = pk2(s[4 * 33], s[5 * 33]); o.w = pk2(s[6 * 33], s[7 * 33]);
        asm volatile("global_store_dwordx4 %0, %1, off sc0 sc1" :: "v"(WT + (size_t)(n0 + n) * ldt + k0 + 8 * c), "v"(o) : "memory"); }
    LDS_WAIT(); asm volatile("" ::: "memory");
}
__device__ __forceinline__ int crow16(int r, int hi) { return (r & 3) + 8 * (r >> 2) + 4 * hi; }
struct LruP { const bf16_t* __restrict__ XL; const bf16_t* __restrict__ GL; const float* __restrict__ cw; const float* __restrict__ cb; const bf16_t* __restrict__ WaT; const bf16_t* __restrict__ WxT;
              const float* __restrict__ ba; const float* __restrict__ bx; const float* __restrict__ lam; f32x2* SUMM; bf16_t* __restrict__ Y; unsigned* __restrict__ LAB; };
__device__ __forceinline__ void lru_scan_groups(const float (&av)[16], const float (&bv)[16], int hi, float (&sA)[8], float (&sB)[8], float& Aw, float& Bw) {
    float Ag[4], Bg[4];
#pragma unroll
    for (int gq = 0; gq < 4; ++gq) { const float a0 = av[4 * gq], a1 = av[4 * gq + 1], a2 = av[4 * gq + 2], a3 = av[4 * gq + 3];
        const float b0 = bv[4 * gq], b1 = bv[4 * gq + 1], b2 = bv[4 * gq + 2], b3 = bv[4 * gq + 3];
        Ag[gq] = (a0 * a1) * (a2 * a3); Bg[gq] = ((b0 * a1 + b1) * a2 + b2) * a3 + b3; }
    Aw = 1.f; Bw = 0.f;
#pragma unroll
    for (int gq = 0; gq < 4; ++gq) { const float oA = __shfl_xor(Ag[gq], 32), oB = __shfl_xor(Bg[gq], 32);
        sA[2 * gq] = hi ? oA : Ag[gq]; sB[2 * gq] = hi ? oB : Bg[gq]; sA[2 * gq + 1] = hi ? Ag[gq] : oA; sB[2 * gq + 1] = hi ? Bg[gq] : oB; }
#pragma unroll
    for (int G = 0; G < 8; ++G) { Bw = sA[G] * Bw + sB[G]; Aw *= sA[G]; }
}
constexpr int LR_XT = 4096, LR_CARRY = LR_XT + 8 * 40 * 144, LR_WA = LR_CARRY + 256, LR_WX = LR_WA + 64 * 144, LR_CW = LR_WX + 64 * 144, LR_CB = LR_CW + 1024, LR_BA = LR_CB + 256, LR_BX = LR_BA + 256, LR_SP = LR_BX + 256;
__device__ __forceinline__ void lru_setup(const LruP& P, LAS unsigned char* lds, int n, int tid) {
    { const int d = tid >> 3, ch = tid & 7;
      *(LAS u32x4*)(lds + LR_WA + d * 144 + ch * 16) = *(const u32x4*)(P.WaT + ((size_t)(n * 64 + d)) * 64 + ch * 8);
      *(LAS u32x4*)(lds + LR_WX + d * 144 + ch * 16) = *(const u32x4*)(P.WxT + ((size_t)(n * 64 + d)) * 64 + ch * 8); }
    if (tid < 256) ((LAS float*)(lds + LR_CW))[tid] = P.cw[(tid >> 6) * LRU_W + n * 64 + (tid & 63)];
    if (tid < 64) { const int ch = n * 64 + tid; ((LAS float*)(lds + LR_CB))[tid] = P.cb[ch]; ((LAS float*)(lds + LR_BA))[tid] = P.ba[ch]; ((LAS float*)(lds + LR_BX))[tid] = P.bx[ch];
        ((LAS float*)(lds + LR_SP))[tid] = -8.0f * LOG2E * log1pf(__expf(-P.lam[ch])); }
    LDS_WAIT(); __syncthreads();
}
struct LruTile { u32x4 v[5]; };
__device__ __forceinline__ void lru_tile_load(const LruP& P, LruTile& T, int unit, int wave, int lane) {
    const int c = unit & 15, n = (unit >> 4) & 7, b = unit >> 7, t0 = c * 256 + wave * 32, rt = lane >> 3, ct = lane & 7;
#pragma unroll
    for (int p = 0; p < 5; ++p) { const int tr = t0 - 3 + 8 * p + rt; T.v[p] = (u32x4){0u, 0u, 0u, 0u};
        if (tr >= 0 && tr < SEQ) T.v[p] = NT_LD(P.XL + ((size_t)b * SEQ + tr) * 512 + n * 64 + ct * 8); }
}
__device__ __forceinline__ void lru_unit_fused(const LruP& P, LAS unsigned char* lds, unsigned* cnt, LruTile& T, int unit, int next_unit, int wave, int lane) {
    const int c = unit & 15, n = (unit >> 4) & 7, b = unit >> 7, r32 = lane & 31, hi = lane >> 5;
    const int t0 = c * 256 + wave * 32; const size_t m0 = (size_t)b * SEQ + t0;
    LAS unsigned char* xt = lds + LR_XT + wave * (40 * 144);
    { const int rt = lane >> 3, ct = lane & 7;
#pragma unroll
      for (int p = 0; p < 5; ++p) *(LAS u32x4*)(xt + (8 * p + rt) * 144 + ct * 16) = T.v[p]; }
    bf16x8 afr[4];
#pragma unroll
    for (int ks = 0; ks < 4; ++ks) { const int cl = 16 * ks + 8 * hi;
        f32x4 x0 = *(const LAS f32x4*)(lds + LR_CB + cl * 4), x1 = *(const LAS f32x4*)(lds + LR_CB + cl * 4 + 16);
#pragma unroll
        for (int k = 0; k < 4; ++k) { const u32x4 w = *(const LAS u32x4*)(xt + (r32 + k) * 144 + (2 * ks + hi) * 16);
            const f32x4 c0 = *(const LAS f32x4*)(lds + LR_CW + (k * 64 + cl) * 4), c1 = *(const LAS f32x4*)(lds + LR_CW + (k * 64 + cl) * 4 + 16);
            x0[0] += c0[0] * bf2f(w.x & 0xffffu); x0[1] += c0[1] * bf2f(w.x >> 16); x0[2] += c0[2] * bf2f(w.y & 0xffffu); x0[3] += c0[3] * bf2f(w.y >> 16);
            x1[0] += c1[0] * bf2f(w.z & 0xffffu); x1[1] += c1[1] * bf2f(w.z >> 16); x1[2] += c1[2] * bf2f(w.w & 0xffffu); x1[3] += c1[3] * bf2f(w.w >> 16); }
        u32x4 pw; pw.x = cvt_pk_bf16(x0[0], x0[1]); pw.y = cvt_pk_bf16(x0[2], x0[3]); pw.z = cvt_pk_bf16(x1[0], x1[1]); pw.w = cvt_pk_bf16(x1[2], x1[3]);
        afr[ks] = __builtin_bit_cast(bf16x8, pw); }
    LAS f32x2* WS = (LAS f32x2*)lds;
    float av[2][16], bv[2][16], sA[2][8], sB[2][8];
#pragma unroll
    for (int cbk = 0; cbk < 2; ++cbk) {
        f32x16 racc = f32x16{}, iacc = f32x16{}, xacc = f32x16{};
        bf16x8 wa[4], wx[4];
#pragma unroll
        for (int ks = 0; ks < 4; ++ks) { const int wo = (32 * cbk + r32) * 144 + (16 * ks + 8 * hi) * 2; wa[ks] = *(const LAS bf16x8*)(lds + LR_WA + wo); wx[ks] = *(const LAS bf16x8*)(lds + LR_WX + wo); }
#pragma unroll
        for (int ks = 0; ks < 4; ++ks) {
            bf16x8 idf;
#pragma unroll
            for (int j = 0; j < 8; ++j) idf[j] = ((16 * ks + 8 * hi + j) == (32 * cbk + r32)) ? (short)0x3F80 : (short)0;
            racc = __builtin_amdgcn_mfma_f32_32x32x16_bf16(afr[ks], wa[ks], racc, 0, 0, 0);
            iacc = __builtin_amdgcn_mfma_f32_32x32x16_bf16(afr[ks], wx[ks], iacc, 0, 0, 0);
            xacc = __builtin_amdgcn_mfma_f32_32x32x16_bf16(afr[ks], idf, xacc, 0, 0, 0); }
        const int chl_ = 32 * cbk + r32; const float bav = ((const LAS float*)(lds + LR_BA))[chl_], bxv = ((const LAS float*)(lds + LR_BX))[chl_], sp8 = ((const LAS float*)(lds + LR_SP))[chl_];
#pragma unroll
        for (int r = 0; r < 16; ++r) { const float rr = sigmoidf_(racc[r] + bav), ig = sigmoidf_(iacc[r] + bxv); const float a = __builtin_amdgcn_exp2f(sp8 * rr);
            float mult = __builtin_amdgcn_sqrtf(fmaxf(__builtin_fmaf(-a, a, 1.0f), 0.f)); if (t0 + crow16(r, hi) == 0) mult = 1.0f;
            av[cbk][r] = a; bv[cbk][r] = mult * ig * xacc[r]; }
        float Aw, Bw; lru_scan_groups(av[cbk], bv[cbk], hi, sA[cbk], sB[cbk], Aw, Bw);
        if (hi == 0) WS[wave * 64 + 32 * cbk + r32] = (f32x2){Aw, Bw};
    }
    LDS_WAIT(); __syncthreads();
    if (next_unit >= 0) lru_tile_load(P, T, next_unit, wave, lane);
    unsigned glv[2][8];
#pragma unroll
    for (int cbk = 0; cbk < 2; ++cbk)
#pragma unroll
        for (int r = 0; r < 16; r += 2) glv[cbk][r >> 1] = (unsigned)__builtin_nontemporal_load(P.GL + (m0 + crow16(r, hi)) * 512 + n * 64 + 32 * cbk + r32) | ((unsigned)__builtin_nontemporal_load(P.GL + (m0 + crow16(r + 1, hi)) * 512 + n * 64 + 32 * cbk + r32) << 16);
    unsigned* cp = cnt + 64 * (b * 8 + n);
    if (wave == 0) {
        float A = 1.f, Bv = 0.f;
#pragma unroll
        for (int w = 0; w < 8; ++w) { const f32x2 ab = WS[w * 64 + lane]; Bv = ab[0] * Bv + ab[1]; A *= ab[0]; }
        __hip_atomic_store((unsigned long long*)(P.SUMM + (size_t)unit * 64 + lane), ((unsigned long long)__float_as_uint(Bv) << 32) | __float_as_uint(A), __ATOMIC_RELAXED, __HIP_MEMORY_SCOPE_AGENT);
        asm volatile("s_waitcnt vmcnt(0)" ::: "memory");
        if (lane == 0) __hip_atomic_fetch_or(cp, 1u << c, __ATOMIC_RELAXED, __HIP_MEMORY_SCOPE_AGENT);
        const unsigned need_ = (1u << c) - 1u; unsigned sp_ = 0;
        while (((unsigned)__builtin_amdgcn_readfirstlane(__hip_atomic_load(cp, __ATOMIC_RELAXED, __HIP_MEMORY_SCOPE_AGENT)) & need_) != need_ && ++sp_ < (1u << 22)) __builtin_amdgcn_s_sleep(1);
        float h = 0.f;
#pragma unroll
        for (int c0 = 0; c0 < 16; c0 += 8) { unsigned long long sm[8];
#pragma unroll
          for (int q = 0; q < 8; ++q) { const int cc = c0 + q; sm[q] = __hip_atomic_load((unsigned long long*)(P.SUMM + (size_t)(unit - c + (cc < c ? cc : 0)) * 64 + lane), __ATOMIC_RELAXED, __HIP_MEMORY_SCOPE_AGENT); }
#pragma unroll
          for (int q = 0; q < 8; ++q) { const int cc = c0 + q; const float A_ = (cc < c) ? __uint_as_float((unsigned)sm[q]) : 1.0f, B_ = (cc < c) ? __uint_as_float((unsigned)(sm[q] >> 32)) : 0.0f; h = A_ * h + B_; } }
        ((LAS float*)(lds + LR_CARRY))[lane] = h;
    }
    LDS_WAIT(); __syncthreads();
#pragma unroll
    for (int cbk = 0; cbk < 2; ++cbk) { const int chl = 32 * cbk + r32;
        float h = ((LAS float*)(lds + LR_CARRY))[chl];
#pragma unroll
        for (int w = 0; w < 7; ++w) { const f32x2 ab = WS[w * 64 + chl]; const float A_ = (w < wave) ? ab[0] : 1.0f, B_ = (w < wave) ? ab[1] : 0.0f; h = A_ * h + B_; }
        float Hs[4];
#pragma unroll
        for (int G = 0; G < 8; ++G) { if ((G & 1) == 0) { if (!hi) Hs[G >> 1] = h; } else { if (hi) Hs[G >> 1] = h; } h = sA[cbk][G] * h + sB[cbk][G]; }
        const int ch = n * 64 + chl;
#pragma unroll
        for (int gq = 0; gq < 4; ++gq) { float hh = Hs[gq];
#pragma unroll
            for (int j = 0; j < 4; j += 2) { const int r = 4 * gq + j; const unsigned gw_ = glv[cbk][r >> 1];
                hh = av[cbk][r] * hh + bv[cbk][r]; const float y0 = hh * gelu_tanh(bf2f(gw_ & 0xffffu));
                hh = av[cbk][r + 1] * hh + bv[cbk][r + 1]; const float y1 = hh * gelu_tanh(bf2f(gw_ >> 16));
                const unsigned wy = cvt_pk_bf16(y0, y1);
                P.Y[(m0 + crow16(r, hi)) * DM + ch] = (bf16_t)(wy & 0xffffu); P.Y[(m0 + crow16(r + 1, hi)) * DM + ch] = (bf16_t)(wy >> 16); } }
    }
    __syncthreads();
}

namespace attn {
using bf16x8_t = bf16x8;
typedef short s16x4 __attribute__((ext_vector_type(4)));
constexpr int D = 64, QP = 512  , NW = 8, QBLK = 32, QB = 256, KVBLK = 64;
constexpr int NSLOT = 3, SLOTB = 8192;
constexpr int LDS_K = 0, LDS_V = NSLOT * SLOTB, LDS_WS = 2 * NSLOT * SLOTB, LDS_OST = LDS_WS + NW * 64 * 4, LDS_BYTES_A = LDS_OST + NW * 4096;
#define SBAR() __builtin_amdgcn_sched_barrier(0)
__device__ __forceinline__ int crow(int r, int hi) { return (r & 3) + 8 * (r >> 2) + 4 * hi; }
__device__ __forceinline__ void cmask(f32x16& p0, f32x16& p1, int jb, int qrel, int hi) {
    const float NEG = -INFINITY; const int kb = 64 * jb + 4 * hi;
#pragma unroll
    for (int r = 0; r < 16; ++r) { const int kv = kb + (r & 3) + 8 * (r >> 2); if (kv > qrel) p0[r] = NEG; if (kv + 32 > qrel) p1[r] = NEG; }
}
__device__ __forceinline__ void glds16(const void* gsrc, unsigned lds_dst) { unsigned keep;
    asm volatile("s_mov_b32 %0, m0\n\ts_mov_b32 m0, %2\n\ts_nop 0\n\tglobal_load_lds_dwordx4 %1, off\n\ts_mov_b32 m0, %0" : "=&s"(keep) : "v"(gsrc), "s"(lds_dst) : "memory"); }
typedef float f32x2_t __attribute__((ext_vector_type(2))); typedef __bf16 bf16x2_t __attribute__((ext_vector_type(2)));
__device__ __forceinline__ unsigned cvtpk_s(float lo, float hi) { f32x2_t v = {lo, hi}; bf16x2_t b = __builtin_convertvector(v, bf16x2_t); return __builtin_bit_cast(unsigned, b); }
#define WAIT_BAR(N) asm volatile("s_waitcnt vmcnt(" #N ") lgkmcnt(0)\n\ts_barrier" ::: "memory")
typedef __attribute__((address_space(3))) const char* lds_cptr;
typedef short v4i16_t __attribute__((ext_vector_type(4)));
__device__ __forceinline__ void kload8(bf16x8* kf, lds_cptr kp) {
    kf[0] = *(const __attribute__((address_space(3))) bf16x8*)(kp);        kf[1] = *(const __attribute__((address_space(3))) bf16x8*)(kp + 512);
    kf[2] = *(const __attribute__((address_space(3))) bf16x8*)(kp + 2048); kf[3] = *(const __attribute__((address_space(3))) bf16x8*)(kp + 2560);
    kf[4] = *(const __attribute__((address_space(3))) bf16x8*)(kp + 4096); kf[5] = *(const __attribute__((address_space(3))) bf16x8*)(kp + 4608);
    kf[6] = *(const __attribute__((address_space(3))) bf16x8*)(kp + 6144); kf[7] = *(const __attribute__((address_space(3))) bf16x8*)(kp + 6656);
}
__device__ __forceinline__ void kload2(bf16x8* kf, lds_cptr kp, int j) { kf[2 * j] = *(const __attribute__((address_space(3))) bf16x8*)(kp + j * 2048); kf[2 * j + 1] = *(const __attribute__((address_space(3))) bf16x8*)(kp + j * 2048 + 512); }
__device__ __forceinline__ s16x4 vtr(lds_cptr p) { return __builtin_bit_cast(s16x4, __builtin_amdgcn_ds_read_tr16_b64_v4i16((__attribute__((address_space(3))) v4i16_t*)p)); }
__device__ __forceinline__ void pv(f32x16* o, int vb, bf16x8 pa0, bf16x8 pa1, bf16x8 pa2, bf16x8 pa3) {
#pragma unroll
    for (int d0 = 0; d0 < 2; ++d0) { s16x4 lo[4], hi[4];
#pragma unroll
        for (int ks = 0; ks < 4; ++ks) {
            asm volatile("ds_read_b64_tr_b16 %0,%1 offset:%c2" : "=&v"(lo[ks]) : "v"(vb), "i"(d0 * 4096 + ks * 1024) : "memory");
            asm volatile("ds_read_b64_tr_b16 %0,%1 offset:%c2" : "=&v"(hi[ks]) : "v"(vb), "i"(d0 * 4096 + ks * 1024 + 512) : "memory"); }
        asm volatile("s_waitcnt lgkmcnt(0)" ::: "memory"); SBAR();
#define PK(k) (bf16x8){lo[k][0], lo[k][1], lo[k][2], lo[k][3], hi[k][0], hi[k][1], hi[k][2], hi[k][3]}
        o[d0] = __builtin_amdgcn_mfma_f32_32x32x16_bf16(pa0, PK(0), o[d0], 0, 0, 0);
        o[d0] = __builtin_amdgcn_mfma_f32_32x32x16_bf16(pa1, PK(1), o[d0], 0, 0, 0);
        o[d0] = __builtin_amdgcn_mfma_f32_32x32x16_bf16(pa2, PK(2), o[d0], 0, 0, 0);
        o[d0] = __builtin_amdgcn_mfma_f32_32x32x16_bf16(pa3, PK(3), o[d0], 0, 0, 0);
#undef PK
    }
}
__device__ __forceinline__ void cinit(f32x16& c0, f32x16& c1, float cbh, float slope2) {
#pragma unroll
    for (int r = 0; r < 16; ++r) { const float kq = (float)((r & 3) + 8 * (r >> 2)); c0[r] = __builtin_fmaf(slope2, kq, cbh); c1[r] = __builtin_fmaf(slope2, kq + 32.0f, cbh); }
}

__device__ __forceinline__ void attn_unit(int b, int h, int qb, const bf16_t* Q, const bf16_t* __restrict__ K, const bf16_t* __restrict__ V, bf16_t* Y, const float* KM, float ref, int t_lo, char* shm, int tid_in) {
    int tid = tid_in; asm volatile("" : "+v"(tid));
    const int lane = tid & 63, r32 = lane & 31, hi = lane >> 5; const int wid = __builtin_amdgcn_readfirstlane(tid >> 6);
    const long rowbase = (long)b * SEQ; const int q0 = qb * QB;
    const bf16_t* Qw = Q + (rowbase + q0 + wid * QBLK) * QP + h * D;
    const bf16_t* Kh = K + (rowbase + (long)t_lo * KVBLK) * QP + h * D; const bf16_t* Vh = V + (rowbase + (long)t_lo * KVBLK) * QP + h * D;
    const unsigned lds0 = (unsigned)(uintptr_t)shm;
    const bf16_t* ksrc = Kh + (long)lane * QP + wid * 8;
    const bf16_t* vsrc = Vh + (long)(16 * (wid & 3) + (lane >> 2)) * QP + (wid >> 2) * 32 + (lane & 3) * 8;
    const unsigned kdst = lds0 + LDS_K + wid * 1024, vdst = lds0 + LDS_V + wid * 1024;
#define DMA_K(t, slot) glds16(ksrc + (long)(t) * KVBLK * QP, (unsigned)__builtin_amdgcn_readfirstlane(kdst + (slot)))
#define DMA_V(t, slot) glds16(vsrc + (long)(t) * KVBLK * QP, (unsigned)__builtin_amdgcn_readfirstlane(vdst + (slot)))
    const int vb0 = (int)(lds0 + LDS_V) + ((lane >> 4) & 1) * 32 + (lane & 3) * 8 + (4 * hi + ((lane & 15) >> 2)) * 64;
    bf16x8 kf[8];
    const lds_cptr shm3 = (lds_cptr)shm; const lds_cptr kp0 = shm3 + LDS_K + hi * 1024 + r32 * 16; const lds_cptr vp0 = shm3 + LDS_V + ((lane >> 4) & 1) * 32 + (lane & 3) * 8 + (4 * hi + ((lane & 15) >> 2)) * 64;
    const int NT = (q0 + QB) / KVBLK - t_lo;
    DMA_K(0, 0); DMA_V(0, 0); DMA_K(1, SLOTB);
    bf16x8 qr[4];
#pragma unroll
    for (int d0 = 0; d0 < 4; ++d0) qr[d0] = *reinterpret_cast<const bf16x8*>(&Qw[(long)r32 * QP + d0 * 16 + hi * 8]);
    unsigned selmask;
    {
        f32x16 gt = f32x16{};
        const float* kmr = KM + ((size_t)(b * NH + h) * 16 + (r32 & 15)) * 64 + 8 * hi;
#pragma unroll
        for (int d0 = 0; d0 < 4; ++d0) {
            f32x4 k0 = *(const f32x4*)(kmr + 16 * d0), k1 = *(const f32x4*)(kmr + 16 * d0 + 4);
            if (r32 >= 16) { k0 = (f32x4){0.f, 0.f, 0.f, 0.f}; k1 = k0; }
            u32x4 wh, wl; float lo8[8], x8[8] = {k0[0], k0[1], k0[2], k0[3], k1[0], k1[1], k1[2], k1[3]}; unsigned hb[8];
#pragma unroll
            for (int j = 0; j < 8; ++j) { hb[j] = f2bf(x8[j]); lo8[j] = x8[j] - bf2f(hb[j]); }
            wh.x = hb[0] | (hb[1] << 16); wh.y = hb[2] | (hb[3] << 16); wh.z = hb[4] | (hb[5] << 16); wh.w = hb[6] | (hb[7] << 16);
            wl.x = pk2(lo8[0], lo8[1]); wl.y = pk2(lo8[2], lo8[3]); wl.z = pk2(lo8[4], lo8[5]); wl.w = pk2(lo8[6], lo8[7]);
            gt = __builtin_amdgcn_mfma_f32_32x32x16_bf16(__builtin_bit_cast(bf16x8, wh), qr[d0], gt, 0, 0, 0);
            gt = __builtin_amdgcn_mfma_f32_32x32x16_bf16(__builtin_bit_cast(bf16x8, wl), qr[d0], gt, 0, 0, 0);
        }
        float g[16];
#pragma unroll
        for (int r = 0; r < 8; ++r) { const float mine = gt[r], oth = __shfl_xor(mine, 32); const int nb = (r & 3) + 8 * (r >> 2);
            g[nb] = hi ? oth : mine; g[nb + 4] = hi ? mine : oth; }
#pragma unroll
        for (int n = 0; n < 16; ++n) if (n >= qb) g[n] = -3.0e38f;
        unsigned m = 0;
#pragma unroll
        for (int s = 0; s < 3; ++s) { float best = g[0]; int bi = 0;
#pragma unroll
            for (int n = 1; n < 16; ++n) if (g[n] > best) { best = g[n]; bi = n; }
            m |= 1u << bi;
#pragma unroll
            for (int n = 0; n < 16; ++n) if (n == bi) g[n] = -INFINITY; }
        selmask = (qb <= 3) ? ((1u << qb) - 1u) : m;
    }
    const float slope2 = __builtin_amdgcn_exp2f(-(float)(h + 1)) * LOG2E;
    const int qrel = wid * QBLK + r32;
    const float tqf = (float)(q0 + qrel);
#define CBH(t) ((((t) >= NT - 4) || ((selmask >> (((t) + t_lo) >> 2)) & 1u)) ? __builtin_fmaf(slope2, (float)(64 * ((t) + t_lo) + 4 * hi) - tqf, -ref) : -1.0e30f)
    float l_reg = 0.f; f32x16 o[2]; o[0] = f32x16{}; o[1] = f32x16{};
#define CMASK(P0, P1, t) do { int jb_ = (t) - (NT - 4); if (jb_ >= 0) cmask(P0, P1, jb_, qrel, hi); } while (0)
    f32x16 pA0, pA1, pB0, pB1;
    int sl_prev = 0, sl_cur = 0, sl_next = SLOTB;
#define ROT() do { sl_prev = sl_cur; sl_cur = sl_next; sl_next = (sl_next == (NSLOT - 1) * SLOTB) ? 0 : sl_next + SLOTB; } while (0)
    DMA_K(2, 2 * SLOTB);
    cinit(pA0, pA1, CBH(0), slope2);
    WAIT_BAR(3);
    { const char* kb = shm + LDS_K + hi * 1024 + r32 * 16;
#pragma unroll
      for (int d0 = 0; d0 < 4; ++d0) { const bf16x8 b0 = *reinterpret_cast<const bf16x8*>(kb + d0 * 2048); const bf16x8 b1 = *reinterpret_cast<const bf16x8*>(kb + d0 * 2048 + 512);
          pA0 = __builtin_amdgcn_mfma_f32_32x32x16_bf16(b0, qr[d0], pA0, 0, 0, 0); pA1 = __builtin_amdgcn_mfma_f32_32x32x16_bf16(b1, qr[d0], pA1, 0, 0, 0); } }
    CMASK(pA0, pA1, 0);
#pragma unroll
    for (int r = 0; r < 16; ++r) { pA0[r] = __builtin_amdgcn_exp2f(pA0[r]); pA1[r] = __builtin_amdgcn_exp2f(pA1[r]); }
    WAIT_BAR(0);
    DMA_K(3, 0); DMA_V(1, SLOTB);
    ROT();
    kload8(kf, kp0 + sl_cur);
    WAIT_BAR(2);
    s16x4 vlo[8], vhi[8]; u32x4 pw0, pw1, pw2, pw3;
#define PKW(P, B) cvtpk_s(P[B], P[B + 1])
#define PAF(k) __builtin_bit_cast(bf16x8, pw##k)
#define VFR(i) (bf16x8){vlo[i][0], vlo[i][1], vlo[i][2], vlo[i][3], vhi[i][0], vhi[i][1], vhi[i][2], vhi[i][3]}
#define PIN(x) asm volatile("" : "+v"(x))
#define GAPA(MF, A0, A1, A2, A3, W0, W1, PW) do { MF; sacc += A0; sacc += A1; sacc += A2; sacc += A3; PIN(sacc); W0; W1; PIN(PW); SBAR(); } while (0)
#define EX(v) __builtin_amdgcn_exp2f(v)
#define GAPB(MF, X, B) do { MF; X[B] = EX(X[B]); X[B + 1] = EX(X[B + 1]); X[B + 2] = EX(X[B + 2]); X[B + 3] = EX(X[B + 3]); PIN(X); SBAR(); } while (0)
#define VRD(i) do { vlo[i] = vtr(vp_ + (((i) >> 2) * 4096 + ((i) & 3) * 1024)); vhi[i] = vtr(vp_ + (((i) >> 2) * 4096 + ((i) & 3) * 1024 + 512)); } while (0)
#define KRD(G, j) do { if (G) { kload2(kf, kp0 + sl_next, j); SBAR(); } } while (0)
#define STEP(C0, C1, P0, P1, t, GK, GV, GL) do { SBAR(); \
    cinit(C0, C1, CBH(t), slope2); SBAR(); \
    const lds_cptr vp_ = vp0 + sl_prev; \
    VRD(0); SBAR(); float sacc = (P0[0] + P0[1]); \
    GAPA(C0 = __builtin_amdgcn_mfma_f32_32x32x16_bf16(kf[0], qr[0], C0, 0, 0, 0), P0[2], P0[3], P0[4], P0[5],     pw0[0] = PKW(P0, 0), pw0[1] = PKW(P0, 2), pw0); \
    VRD(4); SBAR(); GAPA(C1 = __builtin_amdgcn_mfma_f32_32x32x16_bf16(kf[1], qr[0], C1, 0, 0, 0), P0[6], P0[7], P0[8], P0[9],     pw0[2] = PKW(P0, 4), pw0[3] = PKW(P0, 6), pw0); \
    VRD(1); SBAR(); GAPA(C0 = __builtin_amdgcn_mfma_f32_32x32x16_bf16(kf[2], qr[1], C0, 0, 0, 0), P0[10], P0[11], P0[12], P0[13], pw1[0] = PKW(P0, 8), pw1[1] = PKW(P0, 10), pw1); \
    VRD(5); SBAR(); GAPA(C1 = __builtin_amdgcn_mfma_f32_32x32x16_bf16(kf[3], qr[1], C1, 0, 0, 0), P0[14], P0[15], P1[0], P1[1],   pw1[2] = PKW(P0, 12), pw1[3] = PKW(P0, 14), pw1); \
    VRD(2); SBAR(); GAPA(C0 = __builtin_amdgcn_mfma_f32_32x32x16_bf16(kf[4], qr[2], C0, 0, 0, 0), P1[2], P1[3], P1[4], P1[5],     pw2[0] = PKW(P1, 0), pw2[1] = PKW(P1, 2), pw2); \
    VRD(6); SBAR(); GAPA(C1 = __builtin_amdgcn_mfma_f32_32x32x16_bf16(kf[5], qr[2], C1, 0, 0, 0), P1[6], P1[7], P1[8], P1[9],     pw2[2] = PKW(P1, 4), pw2[3] = PKW(P1, 6), pw2); \
    VRD(3); SBAR(); GAPA(C0 = __builtin_amdgcn_mfma_f32_32x32x16_bf16(kf[6], qr[3], C0, 0, 0, 0), P1[10], P1[11], P1[12], P1[13], pw3[0] = PKW(P1, 8), pw3[1] = PKW(P1, 10), pw3); \
    VRD(7); SBAR(); GAPA(C1 = __builtin_amdgcn_mfma_f32_32x32x16_bf16(kf[7], qr[3], C1, 0, 0, 0), P1[14], P1[15], 0.f, 0.f,       pw3[2] = PKW(P1, 12), pw3[3] = PKW(P1, 14), pw3); \
    l_reg += sacc; \
    if (GK) { DMA_K((t) + 3, sl_cur); } if (GV) { DMA_V((t) + 1, sl_next); } \
    CMASK(C0, C1, t); \
    SBAR(); \
    GAPB(o[0] = __builtin_amdgcn_mfma_f32_32x32x16_bf16(PAF(0), VFR(0), o[0], 0, 0, 0), C0, 0); \
    GAPB(o[1] = __builtin_amdgcn_mfma_f32_32x32x16_bf16(PAF(0), VFR(4), o[1], 0, 0, 0), C0, 4); \
    KRD(GL, 0); GAPB(o[0] = __builtin_amdgcn_mfma_f32_32x32x16_bf16(PAF(1), VFR(1), o[0], 0, 0, 0), C0, 8); \
    KRD(GL, 1); GAPB(o[1] = __builtin_amdgcn_mfma_f32_32x32x16_bf16(PAF(1), VFR(5), o[1], 0, 0, 0), C0, 12); \
    KRD(GL, 2); GAPB(o[0] = __builtin_amdgcn_mfma_f32_32x32x16_bf16(PAF(2), VFR(2), o[0], 0, 0, 0), C1, 0); \
    KRD(GL, 3); GAPB(o[1] = __builtin_amdgcn_mfma_f32_32x32x16_bf16(PAF(2), VFR(6), o[1], 0, 0, 0), C1, 4); \
    GAPB(o[0] = __builtin_amdgcn_mfma_f32_32x32x16_bf16(PAF(3), VFR(3), o[0], 0, 0, 0), C1, 8); \
    GAPB(o[1] = __builtin_amdgcn_mfma_f32_32x32x16_bf16(PAF(3), VFR(7), o[1], 0, 0, 0), C1, 12); \
    } while (0)
    int t = 1;
#undef CMASK
#define CMASK(P0, P1, t) do {} while (0)
    for (; t + 5 < NT; t += 2) {
        STEP(pB0, pB1, pA0, pA1, t, true, true, true);     WAIT_BAR(2); ROT();
        STEP(pA0, pA1, pB0, pB1, t + 1, true, true, true); WAIT_BAR(2); ROT();
    }
#undef CMASK
#define CMASK(P0, P1, t) do { int jb_ = (t) - (NT - 4); if (jb_ >= 0) cmask(P0, P1, jb_, qrel, hi); } while (0)
#define ENDW(tt) do { if ((tt) + 3 < NT) { WAIT_BAR(2); } else if ((tt) + 2 < NT) { WAIT_BAR(1); } else { WAIT_BAR(0); } } while (0)
    for (; t + 1 < NT; t += 2) {
        STEP(pB0, pB1, pA0, pA1, t, (t + 3 < NT), (t + 1 < NT), (t + 1 < NT));         ENDW(t);     ROT();
        STEP(pA0, pA1, pB0, pB1, t + 1, (t + 4 < NT), (t + 2 < NT), (t + 2 < NT));     ENDW(t + 1); ROT();
    }
    STEP(pB0, pB1, pA0, pA1, NT - 1, false, false, false);
    { float sacc = pB0[0] + pB0[1];
#pragma unroll
      for (int r = 2; r < 16; ++r) sacc += pB0[r];
#pragma unroll
      for (int r = 0; r < 16; ++r) sacc += pB1[r];
      l_reg += sacc;
      pw0 = (u32x4){PKW(pB0, 0), PKW(pB0, 2), PKW(pB0, 4), PKW(pB0, 6)}; pw1 = (u32x4){PKW(pB0, 8), PKW(pB0, 10), PKW(pB0, 12), PKW(pB0, 14)};
      pw2 = (u32x4){PKW(pB1, 0), PKW(pB1, 2), PKW(pB1, 4), PKW(pB1, 6)}; pw3 = (u32x4){PKW(pB1, 8), PKW(pB1, 10), PKW(pB1, 12), PKW(pB1, 14)};
      SBAR(); pv(o, vb0 + sl_cur, PAF(0), PAF(1), PAF(2), PAF(3)); }
#undef PKW
#undef PAF
#undef VFR
#undef PIN
#undef GAPA
#undef GAPB
#undef EX
#undef VRD
#undef KRD
#undef STEP
#undef ENDW
    { l_reg += __shfl_xor(l_reg, 32); }
    float* wsf = (float*)(shm + LDS_WS) + wid * 64;
    if (hi == 0) wsf[32 + r32] = l_reg; asm volatile("s_waitcnt lgkmcnt(0)" ::: "memory");
    float rli[16];
#pragma unroll
    for (int r = 0; r < 16; ++r) rli[r] = __builtin_amdgcn_rcpf(wsf[32 + crow(r, hi)]);
    bf16_t* Ow = Y + (rowbase + q0 + wid * QBLK) * DM + 512 + h * D;
    { bf16_t* stg = (bf16_t*)(shm + LDS_OST) + wid * 2048;
#pragma unroll
      for (int r = 0; r < 16; ++r) { const int orow = crow(r, hi);
#pragma unroll
          for (int d0 = 0; d0 < 2; ++d0) stg[orow * 64 + d0 * 32 + r32] = (bf16_t)f2bf(o[d0][r] * rli[r]); }
      asm volatile("s_waitcnt lgkmcnt(0)" ::: "memory");
#pragma unroll
      for (int i = 0; i < 4; ++i) { const int row = i * 8 + (lane >> 3), ch = lane & 7; const u32x4 v = *(const u32x4*)(stg + row * 64 + ch * 8); *(u32x4*)(Ow + (long)row * DM + ch * 8) = v; } }
    asm volatile("s_waitcnt lgkmcnt(0)\n\ts_barrier" ::: "memory");
#undef DMA_K
#undef DMA_V
#undef CMASK
#undef CBH
#undef ROT
}
#undef SBAR
#undef WAIT_BAR
}

__device__ constexpr int PROBE_REP[9] = {1, 1, 1, 1, 1, 1, 1, 1, 1};
#define WSP(T, off) ((T*)(a.ws + (off)))
#define P_WT_in WSP(bf16_t, WS_WIN)
#define P_WT_out WSP(bf16_t, WS_WOUT)
#define P_WT_up WSP(bf16_t, WS_WUP)
#define P_WT_dn WSP(bf16_t, WS_WDN)
#define P_WT_g WSP(bf16_t, WS_WG)
#define P_WT_p WSP(bf16_t, WS_WP)
#define P_GW WSP(bf16_t, WS_GW)
#define P_XN WSP(bf16_t, WS_XN)
#define P_PB WSP(bf16_t, WS_PB)
#define P_PRJ WSP(bf16_t, WS_PRJ)
#define CLS_ ((size_t)(blockIdx.x & 7u))
#define P_XL ((bf16_t*)(a.ws + WS_R + CLS_ * SLAB) - CLS_ * SEQ * 512)
#define P_GL (P_XL + (size_t)SEQ * 512)
#define P_Q (P_XL + (size_t)SEQ * 1024)
#define P_K (P_XL + (size_t)SEQ * 1536)
#define P_V (P_XL + (size_t)SEQ * 2048)
#define P_Y ((bf16_t*)(a.ws + WS_R + CLS_ * SLAB + 20 * MiB) - CLS_ * SEQ * DM)
#define P_RINV0 WSP(float, WS_RINV0)
#define P_XB1 ((bf16_t*)(a.ws + WS_R + CLS_ * SLAB) - CLS_ * SEQ * DM)
#define P_XB2 P_XN
#define P_ACT ((bf16_t*)(a.ws + WS_R + CLS_ * SLAB + 8 * MiB) - CLS_ * SEQ * DFF)
#define P_KM WSP(float, WS_KM)
#define P_SS1 WSP(float, WS_SS1)
#define P_SS2 WSP(float, WS_SS2)
#define P_GT WSP(float, WS_GT)
#define P_PART WSP(float, WS_PART)
#define P_VH WSP(float, WS_VH)
__global__ void __launch_bounds__(512, 2) mega(Args a) {
    extern __shared__ __attribute__((aligned(16))) unsigned char lds_raw[];
    LAS unsigned char* const ldsb = (LAS unsigned char*)lds_raw;
    const int wave_s = __builtin_amdgcn_readfirstlane((int)threadIdx.x >> 6);
    volatile LAS unsigned* MISC = (volatile LAS unsigned*)(ldsb + MISC_OFF);
    for (int u = threadIdx.x; u < (LDS_BYTES - RING_BYTES) / 4; u += NWAVES * 64) ((LAS unsigned*)(ldsb + RING_BYTES))[u] = 0u;
    __syncthreads();
    XcdBarrier bar = xcd_barrier_post((unsigned*)(a.ws + WS_CTL), MISC + 8);
    if (gridDim.x != 256u) __builtin_trap();
    const int lo = a.ph_lo, hi_ = a.ph_hi;
#define IN(k) (lo <= (k) && (k) < hi_)
#define REPEAT(k) for (int rep_ = 0; rep_ < PROBE_REP[k]; ++rep_)
#define SEAM(k) do { if (IN(k) && IN((k) + 1)) xcd_barrier(bar); } while (0)
#define PHASE_IDS() int lane_; asm volatile("v_mbcnt_lo_u32_b32 %0, -1, 0\n\tv_mbcnt_hi_u32_b32 %0, -1, %0" : "=&v"(lane_)); const int tid = wave_s * 64 + lane_; const int lane = tid & 63, wave = wave_s; \
    const int G = gridDim.x, vcu = (G % 8 == 0) ? ((int)blockIdx.x % 8) * (G / 8) + (int)blockIdx.x / 8 : (int)blockIdx.x; const int gw = vcu * NWAVES + wave, NGW = G * NWAVES; (void)lane; (void)gw; (void)NGW;

    REPEAT(0) { if (rep_) xcd_barrier(bar);
    if (IN(0)) {
        PHASE_IDS();
        LAS float* scr = (LAS float*)(ldsb + wave * 16384);
        constexpr int I_IN = (DM / 64) * (INW / 32), I_OUT = (DM / 64) * (DM / 32), I_UP = (DM / 64) * (2 * DFF / 32), I_DN = (DFF / 64) * (DM / 32), I_G = I_OUT, I_P = (PLE / 64) * (DM / 32), I_GW = 16 * 2;
        constexpr int NITEMS = I_IN + I_OUT + I_UP + I_DN + I_G + I_P + I_GW;
        for (int it = gw; it < NITEMS; it += NGW) {
            int r = it;
            if (r < I_IN) { p0_transpose_item(a.in[3], INW, INW, P_WT_in, DM, nullptr, scr, r, lane); continue; } r -= I_IN;
            if (r < I_OUT) { p0_transpose_item(a.in[13], DM, DM, P_WT_out, DM, nullptr, scr, r, lane); continue; } r -= I_OUT;
            if (r < I_UP) { p0_transpose_item(a.in[15], 2 * DFF, 2 * DFF, P_WT_up, DM, a.in[14], scr, r, lane); continue; } r -= I_UP;
            if (r < I_DN) { p0_transpose_item(a.in[18], DM, DM, P_WT_dn, DFF, nullptr, scr, r, lane); continue; } r -= I_DN;
            if (r < I_G) { p0_transpose_item(a.in[20], DM, DM, P_WT_g, DM, a.in[19], scr, r, lane); continue; } r -= I_G;
            if (r < I_P) { p0_transpose_item(a.in[21], DM, DM, P_WT_p, PLE, nullptr, scr, r, lane); continue; } r -= I_P;
            { const int mat = r >> 1, sub = r & 1, gsel = mat >> 3, blk = mat & 7;
              p0_transpose_item((gsel ? a.in[8] : a.in[6]) + (size_t)blk * 4096, 64, 64, P_GW + (size_t)gsel * 32768 + (size_t)blk * 4096, 64, nullptr, scr, sub, lane); }
        }
        VM_WAIT(); __syncthreads();
        if (tid == 0) (void)xb_add((unsigned*)(a.ws + WS_CTL) + GB_WCNT, 1u);
        const int cls = vcu >> 5, cw = (vcu & 31) * NWAVES + wave;
        { const int i = cw * 64 + lane; if (i < NH * 16 * 64) P_KM[cls * (NH * 16 * 64) + i] = 0.f; }
        { const float* xin = a.in[0]; const f32x4* gr = (const f32x4*)a.in[2] + lane; bf16_t* xn = P_XN; float* rinv = P_RINV0;
          f32x4 gg[4];
#pragma unroll
          for (int j = 0; j < 4; ++j) gg[j] = gr[64 * j];
          constexpr int CNW = 32 * NWAVES; const int mend = (cls + 1) * SEQ;
          for (int m0 = cls * SEQ + cw; m0 < mend; m0 += 4 * CNW) {
              f32x4 v[4][4];
#pragma unroll
              for (int r = 0; r < 4; ++r) { const int m = m0 + r * CNW; const f32x4* xr = (const f32x4*)(xin + (size_t)(m < mend ? m : m0) * DM) + lane;
#pragma unroll
                  for (int j = 0; j < 4; ++j) v[r][j] = __builtin_nontemporal_load(xr + 64 * j); }
#pragma unroll
              for (int r = 0; r < 4; ++r) { const int m = m0 + r * CNW; float s = 0.f;
#pragma unroll
                  for (int j = 0; j < 4; ++j) s += (v[r][j][0] * v[r][j][0] + v[r][j][1] * v[r][j][1]) + (v[r][j][2] * v[r][j][2] + v[r][j][3] * v[r][j][3]);
                  const float ms = wave_sum(s) * (1.0f / DM) + EPS; const float rstd = rsqrtf(ms);
                  if (m < mend) { if (lane == 0) rinv[m] = ms * rstd;
                      unsigned long long* o8 = (unsigned long long*)(xn + (size_t)m * DM) + lane;
#pragma unroll
                      for (int j = 0; j < 4; ++j) o8[64 * j] = (unsigned long long)pk2(v[r][j][0] * rstd * gg[j][0], v[r][j][1] * rstd * gg[j][1]) | ((unsigned long long)pk2(v[r][j][2] * rstd * gg[j][2], v[r][j][3] * rstd * gg[j][3]) << 32); } } } }
        { const f32x4* pin = (const f32x4*)a.in[1]; unsigned long long* pb = (unsigned long long*)P_PB; const size_t n4 = (size_t)(cls + 1) * SEQ * PLE / 4, st = (size_t)32 * NWAVES * 64;
          for (size_t i0 = (size_t)cls * SEQ * PLE / 4 + (size_t)cw * 64 + lane; i0 < n4; i0 += 8 * st) { f32x4 v[8];
#pragma unroll
              for (int q = 0; q < 8; ++q) { const size_t i = i0 + q * st; v[q] = __builtin_nontemporal_load(pin + (i < n4 ? i : i0)); }
#pragma unroll
              for (int q = 0; q < 8; ++q) { const size_t i = i0 + q * st; if (i < n4) pb[i] = (unsigned long long)pk2(v[q][0], v[q][1]) | ((unsigned long long)pk2(v[q][2], v[q][3]) << 32); } } }
    }
    }
    if (IN(0) && IN(1)) {
        if (threadIdx.x == 0) { unsigned* bar_ = (unsigned*)(a.ws + WS_CTL); XB_SPIN(xb_ld(&bar_[GB_WCNT]) < gridDim.x, bar_); }
        grp_barrier((unsigned*)(a.ws + WS_CTL), MISC + 10, false); }
    REPEAT(1) { if (rep_) xcd_barrier(bar);
    if (IN(1)) {
        { PHASE_IDS(); pg8::Gemm g{P_XN, P_WT_in, 0, MTOK, INW, DM, 0}; pg8::StaticOrder S; S.init(MTOK, INW, G, (int)blockIdx.x); EpiInProj E{P_XL, a.in[11], a.in[12], P_KM};
          pg8::gemm_phase<EpiInProj, true>(ldsb, g, S, E, tid); }
        { PHASE_IDS(); pg8::Gemm g{P_PB, P_WT_p, 0, MTOK, DM, PLE, 0}; pg8::StaticOrder S; S.init(MTOK, DM, G, (int)blockIdx.x); EpiBf16Plain E{P_PRJ, 0};
          pg8::gemm_phase<EpiBf16Plain, true>(ldsb, g, S, E, tid); }
    }
    }
    do { if (IN(1) && IN(3)) grp_barrier((unsigned*)(a.ws + WS_CTL), MISC + 10, false); } while (0);
    REPEAT(3) { if (rep_) xcd_barrier(bar);
    if (IN(3)) {
        { PHASE_IDS(); unsigned* cntL = (unsigned*)(a.ws + WS_CTL) + 4096;
          const LruP LP{P_XL, P_GL, a.in[4], a.in[5], P_GW, P_GW + 32768, a.in[7], a.in[9], a.in[10], WSP(f32x2, WS_SUMM), P_Y, (unsigned*)a.out};
          {
            const int l_ = vcu & 31, u0 = ((vcu >> 5) << 7) | ((l_ >> 2) << 4) | (l_ & 3);
            lru_setup(LP, ldsb, l_ >> 2, tid);
            LruTile T; lru_tile_load(LP, T, u0, wave, lane);
#pragma nounroll
            for (int u = u0; u < u0 + 16; u += 4) lru_unit_fused(LP, ldsb, cntL, T, u, (u + 4 < u0 + 16) ? u + 4 : -1, wave, lane); } }
        { PHASE_IDS();
          float mq = fabsf(a.in[11][lane]), mk = fabsf(a.in[12][lane]); mq = wave_max(mq); mk = wave_max(mk);
          const float ref = C2 * 64.0f * mq * mk;
          LAS int* QL = (LAS int*)(ldsb + attn::LDS_BYTES_A);
#define ATT_TLO(h_, qb_) ({ const float ds_ = (2.0f * ref + 40.0f) / (exp2f(-(float)((h_) + 1)) * LOG2E); const float sm_ = (float)((qb_) * 256) - ds_; int tl_ = sm_ > 0.f ? (int)(sm_ * (1.0f / 64.0f)) : 0; tl_ &= ~1; tl_ = tl_ > 4 * (qb_) ? 4 * (qb_) : tl_; tl_; })
          if (tid < 128) QL[tid] = 4 * ((tid & 15) + 1) - ATT_TLO(tid >> 4, tid & 15);
          __syncthreads();
          if (tid < 128) { const int my = QL[tid]; int rank = 0; for (int j = 0; j < 128; ++j) { const int cj = QL[j]; rank += (cj > my || (cj == my && j < tid)) ? 1 : 0; } QL[128 + rank] = tid; }
          __syncthreads();
          unsigned* qctr = (unsigned*)(a.ws + WS_CTL) + 8192 + 64 * ((int)blockIdx.x & 7);
          for (;;) {
              if (tid == 0) QL[256] = (int)__hip_atomic_fetch_add(qctr, 1u, __ATOMIC_RELAXED, __HIP_MEMORY_SCOPE_AGENT);
              __syncthreads();
              const int k = QL[256];
              __syncthreads();
              if (k >= NH * 16) break;
              const int combo = __builtin_amdgcn_readfirstlane(QL[128 + k]), b = (int)blockIdx.x & 7, h = combo >> 4, qb = combo & 15;
              const int tlo = __builtin_amdgcn_readfirstlane(ATT_TLO(h, qb));
              attn::attn_unit(b, h, qb, P_Q, P_K, P_V, P_Y, P_KM, ref, tlo, (char*)lds_raw, tid); }
#undef ATT_TLO
        }
    }
    }
    do { if (IN(3) && IN(4)) grp_barrier((unsigned*)(a.ws + WS_CTL), MISC + 10, false); } while (0);
    REPEAT(4) { if (rep_) xcd_barrier(bar);
    if (IN(4)) { PHASE_IDS(); pg8::Gemm g{P_Y, P_WT_out, 0, MTOK, DM, DM, 0}; pg8::StaticOrder S; S.init(MTOK, DM, G, (int)blockIdx.x); EpiResid<2> E{P_XN, P_XB1, P_SS1, P_RINV0, a.in[2]};
        pg8::gemm_phase<EpiResid<2>, true>(ldsb, g, S, E, tid); }
    }
    do { if (IN(4) && IN(5)) grp_barrier((unsigned*)(a.ws + WS_CTL), MISC + 10, true); } while (0);
    REPEAT(5) { if (rep_) xcd_barrier(bar);
    if (IN(5)) { PHASE_IDS(); pg8::Gemm g{P_XB1, P_WT_up, (size_t)DFF * DM * 2, MTOK, 2 * DFF, DM, 0}; pg8::StaticOrder S; S.init(MTOK, 2 * DFF, G, (int)blockIdx.x);
        pg8::Unit u0, u1; const int nun = (S.nwg - (int)blockIdx.x + G - 1) / G; S.next(0, u0); S.next(nun - 1, u1);
        { const int row = (tid < 256 ? u0.pm : u1.pm) * 256 + (tid & 255); const f32x4* sp = (const f32x4*)(P_SS1 + (size_t)row * 16); const f32x4 p0 = sp[0], p1 = sp[1], p2 = sp[2], p3 = sp[3];
          const float s = ((p0[0] + p0[1]) + (p0[2] + p0[3])) + ((p1[0] + p1[1]) + (p1[2] + p1[3])) + (((p2[0] + p2[1]) + (p2[2] + p2[3])) + ((p3[0] + p3[1]) + (p3[2] + p3[3])));
          ((LAS float*)(ldsb + SPARE_RS))[tid] = rsqrtf(s * (1.0f / DM) + EPS); }
        __syncthreads();
        bool two = true; { pg8::Unit uq; for (int i_ = 0; S.next(i_, uq); ++i_) two = two && (uq.pm == u0.pm || uq.pm == u1.pm); }
        EpiUpFused E{P_ACT, a.in[16], a.in[17], P_GT, P_PART, P_VH, P_SS1, u0.pm, two ? u1.pm : -1};
        pg8::gemm_phase<EpiUpFused, true>(ldsb, g, S, E, tid); }
    }
    do { if (IN(5) && IN(7)) grp_barrier((unsigned*)(a.ws + WS_CTL), MISC + 10, true); } while (0);
    if (IN(7)) { PHASE_IDS(); pg8::Gemm g{P_ACT, P_WT_dn, 0, MTOK, DM, DFF, 0}; pg8::StaticOrder S; S.init(MTOK, DM, G, (int)blockIdx.x);
        { const float* GT = P_GT; const float* PART = P_PART; const float* VH = P_VH; const float* fcw = a.in[16]; bf16_t* ACT = P_ACT;
          pg8::Unit uu; for (int ui_ = 0; S.next(ui_, uu); ++ui_) {
#pragma unroll
              for (int it_ = 0; it_ < 4 * (DFF / 4) / (NWAVES * 64); ++it_) { const int i = tid + it_ * NWAVES * 64; const int c4 = i % (DFF / 4), sr4 = i / (DFF / 4), rr = sr4 & 1, strip = uu.pm * 2 + (sr4 >> 1), sr = strip * 2 + rr, j = c4 * 4, r0 = strip * 128;
                  f32x4 pre = __builtin_nontemporal_load((const f32x4*)(PART + (size_t)sr * DFF + j)); const f32x4 v = __builtin_nontemporal_load((const f32x4*)(VH + (size_t)sr * DFF + j));
                  if ((r0 & (SEQ - 1)) != 0) { const f32x4 p2 = *(const f32x4*)(GT + ((size_t)(strip - 1) * 2 + 0) * DFF + j), p1 = *(const f32x4*)(GT + ((size_t)(strip - 1) * 2 + 1) * DFF + j);
                      const f32x4 w0 = *(const f32x4*)(fcw + j), w1 = *(const f32x4*)(fcw + DFF + j);
                      if (rr == 0) pre = pre + w0 * p2 + w1 * p1; else pre = pre + w0 * p1; }
                  u32x2 w; w.x = pk2(gelu_tanh(pre[0]) * v[0], gelu_tanh(pre[1]) * v[1]); w.y = pk2(gelu_tanh(pre[2]) * v[2], gelu_tanh(pre[3]) * v[3]);
                  *(u32x2*)(ACT + (size_t)(r0 + rr) * DFF + j) = w; } }
          VM_WAIT(); __syncthreads(); }
        EpiResid<1> E{P_XB1, P_XB2, P_SS2, nullptr, nullptr};
        pg8::gemm_phase<EpiResid<1>, true>(ldsb, g, S, E, tid); }
    do { if (IN(7) && IN(8)) grp_barrier((unsigned*)(a.ws + WS_CTL), MISC + 10, true); } while (0);
    if (IN(8)) { PHASE_IDS(); pg8::Gemm g{P_XB2, P_WT_g, 0, MTOK, DM, DM, 0}; pg8::StaticOrder S; S.init(MTOK, DM, G, (int)blockIdx.x); EpiFinal E{a.out, P_XB2, P_PRJ, P_SS2};
        pg8::gemm_phase<EpiFinal, true>(ldsb, g, S, E, tid); }
#undef IN
#undef SEAM
}

#ifndef MK_N_LAUNCHES
#define MK_N_LAUNCHES 1
#endif
constexpr int N_PHASES = 9;
extern "C" void kernel_launch(void* const* d_in, const int* in_sizes, int n_in, void* d_out, int out_size, void* d_ws, size_t ws_size, hipStream_t stream) {
    static int grid = 0;
    if (grid == 0) {
        if (n_in != 22 || ws_size < WS_END || out_size != MTOK * DM) { fprintf(stderr, "kernel_launch: unexpected n_in %d, out_size %d or ws_size %zu\n", n_in, out_size, ws_size); grid = -1; return; }
        int dev = 0, cus = 0, per_cu = 0;
        if (hipGetDevice(&dev) != hipSuccess || hipDeviceGetAttribute(&cus, hipDeviceAttributeMultiprocessorCount, dev) != hipSuccess) { grid = -1; return; }
        if (hipFuncSetAttribute((const void*)mega, hipFuncAttributeMaxDynamicSharedMemorySize, LDS_BYTES) != hipSuccess) { fprintf(stderr, "kernel_launch: hipFuncSetAttribute failed\n"); grid = -1; return; }
        if (hipOccupancyMaxActiveBlocksPerMultiprocessor(&per_cu, (const void*)mega, NWAVES * 64, LDS_BYTES) != hipSuccess || per_cu < 1) fprintf(stderr, "kernel_launch: occupancy query says %d\n", per_cu);
        (void)hipGetLastError();
        grid = cus >= 128 ? (cus / 128) * 128 : cus;
    }
    if (grid < 0) return;
    (void)hipMemsetAsync((char*)d_ws + WS_CTL, 0, CTL_ZERO_BYTES, stream);
    Args a{};
    for (int i = 0; i < 22; ++i) a.in[i] = (const float*)d_in[i];
    a.out = (float*)d_out; a.ws = (unsigned char*)d_ws;
    if (MK_N_LAUNCHES == 1) { a.ph_lo = 0; a.ph_hi = N_PHASES; hipLaunchKernelGGL(mega, dim3(grid), dim3(NWAVES * 64), LDS_BYTES, stream, a); }
    else { for (int ph = 0; ph < N_PHASES; ++ph) { a.ph_lo = ph; a.ph_hi = ph + 1; hipLaunchKernelGGL(mega, dim3(grid), dim3(NWAVES * 64), LDS_BYTES, stream, a); } }
}
```

```cpp
#include <hip/hip_runtime.h>
#include <cstdio>
#include <cstdint>

constexpr int BATCH = 8, SEQ = 4096, DM = 1024, MTOK = BATCH * SEQ;
constexpr int LRU_W = 512, ATT_W = 512, NH = 8, HD = 64, INW = 2560, DFF = 3072, PLE = 256;
constexpr float EPS = 1e-6f;
constexpr float LOG2E = 1.4426950408889634f;
constexpr float C2 = 0.125f * LOG2E;

typedef unsigned short bf16_t;
typedef short bf16x8 __attribute__((ext_vector_type(8)));
typedef float f32x4 __attribute__((ext_vector_type(4)));
typedef float f32x2 __attribute__((ext_vector_type(2)));
typedef unsigned u32x4 __attribute__((ext_vector_type(4)));
typedef unsigned u32x2 __attribute__((ext_vector_type(2)));

__device__ __forceinline__ unsigned f2bf(float f) { unsigned u = __builtin_bit_cast(unsigned, f); return (u + 0x7fffu + ((u >> 16) & 1u)) >> 16; }
__device__ __forceinline__ unsigned pk2(float lo, float hi) { return f2bf(lo) | (f2bf(hi) << 16); }
__device__ __forceinline__ float bf2f(unsigned v) { return __builtin_bit_cast(float, v << 16); }
__device__ __forceinline__ float gelu_tanh(float x) {
    const float u2 = x * (-1.5957691216f * LOG2E - 0.0713548163f * LOG2E * x * x);
    return x * __builtin_amdgcn_rcpf(1.0f + __builtin_amdgcn_exp2f(u2));
}
__device__ __forceinline__ float sigmoidf_(float x) { return __builtin_amdgcn_rcpf(1.0f + __builtin_amdgcn_exp2f(-LOG2E * x)); }

namespace pg8 {
#define PG8_LAS __attribute__((address_space(3)))
constexpr int BM = 256, BK = 64, HALF = 128, HTB = HALF * BK * 2, STAGE_BYTES = 8 * HTB, NXCD = 8, WGM = 8;

__host__ __device__ __forceinline__ int lds_byte(int r, int c) { const int st = (r >> 4) * 2 + (c >> 5), rr = r & 15, cc = c & 31, ob = rr * 64 + cc * 2; return st * 1024 + (ob ^ (((ob >> 9) & 1) << 5)); }
__host__ __device__ __forceinline__ void stage_rc(int b, int& R, int& C) { const int st = b / 1024, sb = b % 1024, swz = sb ^ (((sb >> 9) & 1) << 5); R = (st >> 1) * 16 + swz / 64; C = (st & 1) * 32 + (swz % 64) / 2; }
__host__ __device__ __forceinline__ int perm32(int rho) { const int n = rho >> 4, i = rho & 15; return 8 * (i >> 2) + 4 * n + (i & 3); }

struct Unit { int pm, pn; };
struct Gemm { const bf16_t* A; const bf16_t* Bt; size_t bhalf; int M, N, K, pad; };

struct StaticOrder {
    int nM, nN, nwg, G, c;
    __host__ __device__ void init(int M, int N, int G_, int c_) { nM = M / BM; nN = N / BM; nwg = nM * nN; G = G_; c = c_; }
    __host__ __device__ bool next(int i, Unit& u) const {
        const long L = (long)i * G + c; if (L >= nwg) return false;
        int wgid = (int)L; { const int q = nwg / NXCD, r = nwg % NXCD, xcd = wgid % NXCD, off = wgid / NXCD; wgid = (xcd < r ? xcd * (q + 1) : r * (q + 1) + (xcd - r) * q) + off; }
        const int nig = WGM * nN, gid = wgid / nig, fm = gid * WGM, gsz = (nM - fm) < WGM ? (nM - fm) : WGM;
        u.pm = fm + ((wgid % nig) % gsz); u.pn = (wgid % nig) / gsz; return true;
    }
};

template <class Epi, bool ALIGN_EPI>
__device__ __forceinline__ void gemm_phase(PG8_LAS unsigned char* lds, const Gemm g, const StaticOrder& S, const Epi& E, const int tid) {
    const int wid = __builtin_amdgcn_readfirstlane(tid >> 6), lane = tid & 63, wr = wid >> 2, wc = wid & 3, fr = lane & 15, fq = lane >> 4;
    const int K = g.K, nt = K / BK;
    unsigned voffA[2], voffB[2];
#pragma unroll
    for (int i = 0; i < 2; ++i) { int R, C; stage_rc(tid * 16 + i * 8192, R, C);
        const int Ra = Epi::ASIG ? (128 * (R >> 6) + 8 * (R & 15) + ((R >> 4) & 3)) : R;
        const int Rb = (Epi::BMODE == 1) ? (64 * (R >> 5) + perm32(R & 31)) : (Epi::PERM ? ((R & ~31) + perm32(R & 31)) : R);
        voffA[i] = (unsigned)(Ra * K + C) * 2u; voffB[i] = (unsigned)(Rb * K + C) * 2u; }
    const size_t kstep = (size_t)(BK * 2);
    const size_t hstepA = Epi::ASIG ? (size_t)4 * K * 2 : (size_t)HALF * K * 2;
    const size_t hstepB = (Epi::BMODE == 1) ? (size_t)32 * K * 2 : ((Epi::BMODE == 2) ? g.bhalf : (size_t)HALF * K * 2);
    const size_t tstepA = (size_t)BM * K * 2;
    const size_t tstepB = (Epi::BMODE == 2) ? (size_t)HALF * K * 2 : (size_t)BM * K * 2;
    const unsigned ldsw = (unsigned)wid * 1024u;
    const int aoff = lds_byte(wr * 64 + fr, fq * 8), boff = lds_byte(wc * 32 + fr, fq * 8);
#define PG8_SA(b, h) (((b) * 2 + (h)) * HTB)
#define PG8_SB(b, h) ((4 + (b) * 2 + (h)) * HTB)
#define PG8_STAGE(bufoff, gbase, voff) do { _Pragma("unroll") for (int _i = 0; _i < 2; ++_i) \
        __builtin_amdgcn_global_load_lds((const unsigned*)((const char*)(gbase) + (voff)[_i]), (PG8_LAS unsigned*)(lds + (bufoff) + ldsw + _i * 8192), 16, 0, 0); } while (0)
#define PG8_LDA(dst, b, h) do { _Pragma("unroll") for (int m = 0; m < 4; ++m) _Pragma("unroll") for (int k = 0; k < 2; ++k) dst[m][k] = *(const PG8_LAS bf16x8*)(lds + PG8_SA(b, h) + aoff + m * 2048 + k * 1024); } while (0)
#define PG8_LDB(dst, b, h) do { _Pragma("unroll") for (int n = 0; n < 2; ++n) _Pragma("unroll") for (int k = 0; k < 2; ++k) dst[n][k] = *(const PG8_LAS bf16x8*)(lds + PG8_SB(b, h) + boff + n * 2048 + k * 1024); } while (0)
#define PG8_MMA(ai, bj, At, Bt) do { __builtin_amdgcn_s_setprio(1); _Pragma("unroll") for (int m = 0; m < 4; ++m) _Pragma("unroll") for (int n = 0; n < 2; ++n) _Pragma("unroll") for (int k = 0; k < 2; ++k) \
        acc[ai][bj][m][n] = __builtin_amdgcn_mfma_f32_16x16x32_bf16(Bt[n][k], At[m][k], acc[ai][bj][m][n], 0, 0, 0); __builtin_amdgcn_s_setprio(0); } while (0)
#define PG8_WAIT_V(n) asm volatile("s_waitcnt vmcnt(" #n ")" ::: "memory")
#define PG8_WAIT_L(n) asm volatile("s_waitcnt lgkmcnt(" #n ")" ::: "memory")
#define PG8_BAR __builtin_amdgcn_s_barrier()
#define PG8_SCHED __builtin_amdgcn_sched_barrier(0)
    Unit cur, nxt; int ui = 0;
    if (!S.next(0, cur)) return;
    f32x4 acc[2][2][4][2];
#pragma unroll
    for (int a = 0; a < 2; ++a)
#pragma unroll
        for (int b = 0; b < 2; ++b)
#pragma unroll
            for (int m = 0; m < 4; ++m)
#pragma unroll
                for (int n = 0; n < 2; ++n) acc[a][b][m][n] = (f32x4){0.f, 0.f, 0.f, 0.f};
    bf16x8 At[4][2], B0[2][2], B1[2][2];
    const char* cA = (const char*)g.A + (size_t)cur.pm * tstepA; const char* cB = (const char*)g.Bt + (size_t)cur.pn * tstepB;
    if constexpr (Epi::HAS_PRE) E.pre(lds, cur, ui, wid, lane);
    PG8_STAGE(PG8_SB(0, 0), cB, voffB); PG8_STAGE(PG8_SB(0, 1), cB + hstepB, voffB); PG8_STAGE(PG8_SA(0, 0), cA, voffA); PG8_STAGE(PG8_SA(0, 1), cA + hstepA, voffA);
    if (wr == 1) PG8_BAR;
    PG8_WAIT_V(2); PG8_BAR;
    PG8_STAGE(PG8_SB(1, 0), cB + kstep, voffB); PG8_STAGE(PG8_SA(1, 0), cA + kstep, voffA); PG8_STAGE(PG8_SB(1, 1), cB + hstepB + kstep, voffB);
    PG8_WAIT_V(6); PG8_BAR;
    for (;;) {
        const bool has_next = S.next(ui + 1, nxt);
        const char* nA = has_next ? (const char*)g.A + (size_t)nxt.pm * tstepA : cA; const char* nB = has_next ? (const char*)g.Bt + (size_t)nxt.pn * tstepB : cB;
        for (int t = 0; t < nt; t += 2) {
            const bool last = (t == nt - 2);
            const char* a1 = cA + (size_t)(t + 1) * kstep;
            const char* a2 = last ? nA : cA + (size_t)(t + 2) * kstep; const char* b2 = last ? nB : cB + (size_t)(t + 2) * kstep;
            const char* a3 = a2 + kstep; const char* b3 = b2 + kstep;
            PG8_LDB(B0, 0, 0); PG8_LDB(B1, 0, 1); PG8_SCHED; PG8_LDA(At, 0, 0); PG8_STAGE(PG8_SA(1, 1), a1 + hstepA, voffA);
            PG8_WAIT_V(8); PG8_WAIT_L(0); PG8_BAR; PG8_MMA(0, 0, At, B0); PG8_MMA(0, 1, At, B1); PG8_BAR; PG8_SCHED;
            PG8_LDA(At, 0, 1); PG8_STAGE(PG8_SB(0, 0), b2, voffB); PG8_STAGE(PG8_SB(0, 1), b2 + hstepB, voffB); PG8_STAGE(PG8_SA(0, 0), a2, voffA);
            PG8_WAIT_V(8); PG8_WAIT_L(0); PG8_BAR; PG8_MMA(1, 0, At, B0); PG8_MMA(1, 1, At, B1); PG8_BAR; PG8_SCHED;
            PG8_LDB(B0, 1, 0); PG8_LDB(B1, 1, 1); PG8_SCHED; PG8_LDA(At, 1, 0); PG8_STAGE(PG8_SA(0, 1), a2 + hstepA, voffA);
            PG8_WAIT_V(8); PG8_WAIT_L(0); PG8_BAR; PG8_MMA(0, 0, At, B0); PG8_MMA(0, 1, At, B1); PG8_BAR; PG8_SCHED;
            PG8_LDA(At, 1, 1); PG8_STAGE(PG8_SB(1, 0), b3, voffB); PG8_STAGE(PG8_SB(1, 1), b3 + hstepB, voffB); PG8_STAGE(PG8_SA(1, 0), a3, voffA);
            PG8_WAIT_V(8); PG8_WAIT_L(0); PG8_BAR; PG8_MMA(1, 0, At, B0); PG8_MMA(1, 1, At, B1); PG8_BAR; PG8_SCHED;
        }
        if constexpr (ALIGN_EPI) { if (wr == 0) PG8_BAR; }
        if constexpr (Epi::HAS_PRE) E.run(acc, cur, ui, lds, wr, wc, fr, fq); else E(acc, cur, wr, wc, fr, fq);
        if (!has_next) break;
#pragma unroll
        for (int a = 0; a < 2; ++a)
#pragma unroll
            for (int b = 0; b < 2; ++b)
#pragma unroll
                for (int m = 0; m < 4; ++m)
#pragma unroll
                    for (int n = 0; n < 2; ++n) acc[a][b][m][n] = (f32x4){0.f, 0.f, 0.f, 0.f};
        cur = nxt; cA = nA; cB = nB; ++ui;
        if constexpr (Epi::HAS_PRE) E.pre(lds, cur, ui, wid, lane);
        if constexpr (ALIGN_EPI) { if (wr == 1) PG8_BAR; }
    }
    PG8_WAIT_V(0);
    if constexpr (!ALIGN_EPI) { if (wr == 0) PG8_BAR; }
    PG8_BAR;
#undef PG8_SA
#undef PG8_SB
#undef PG8_STAGE
#undef PG8_LDA
#undef PG8_LDB
#undef PG8_MMA
#undef PG8_WAIT_V
#undef PG8_WAIT_L
#undef PG8_BAR
#undef PG8_SCHED
}
}

__device__ __forceinline__ unsigned cvt_pk_bf16(float lo, float hi) { unsigned r; asm volatile("v_cvt_pk_bf16_f32 %0, %1, %2" : "=v"(r) : "v"(lo), "v"(hi)); return r; }
constexpr int SPARE_RS = 131072 + 1024, SPARE_CW = SPARE_RS + 2048, SPARE_ST = SPARE_CW + 4096, ST_ROW = 144, ST_WAVE = 16 * ST_ROW;
static_assert(SPARE_ST + 8 * ST_WAVE <= 163840, "LDS map");
__device__ __forceinline__ void st_rows_to_lane16(PG8_LAS unsigned char* wb, u32x4 r0, u32x4 r1, int fr, int fq, int rt, int ct, u32x4& p0, u32x4& p1) {
    *(PG8_LAS u32x4*)(wb + rt * ST_ROW + ct * 16) = r0; *(PG8_LAS u32x4*)(wb + (rt + 8) * ST_ROW + ct * 16) = r1;
    p0 = *(const PG8_LAS u32x4*)(wb + fr * ST_ROW + fq * 16); p1 = *(const PG8_LAS u32x4*)(wb + fr * ST_ROW + 64 + fq * 16);
}
__device__ __forceinline__ void st_lane16_to_rows(PG8_LAS unsigned char* wb, u32x4 p0, u32x4 p1, int fr, int fq, int rt, int ct, u32x4& r0, u32x4& r1) {
    *(PG8_LAS u32x4*)(wb + fr * ST_ROW + fq * 16) = p0; *(PG8_LAS u32x4*)(wb + fr * ST_ROW + 64 + fq * 16) = p1;
    r0 = *(const PG8_LAS u32x4*)(wb + rt * ST_ROW + ct * 16); r1 = *(const PG8_LAS u32x4*)(wb + (rt + 8) * ST_ROW + ct * 16);
}
__device__ __forceinline__ void st_rows_to_lane32(PG8_LAS unsigned char* wb, u32x4 r0, u32x4 r1, int fr, int fq, int rt, int ct, u32x4& p0, u32x4& p1) {
    *(PG8_LAS u32x4*)(wb + rt * ST_ROW + ct * 16) = r0; *(PG8_LAS u32x4*)(wb + (rt + 8) * ST_ROW + ct * 16) = r1;
    p0 = *(const PG8_LAS u32x4*)(wb + fr * ST_ROW + fq * 32); p1 = *(const PG8_LAS u32x4*)(wb + fr * ST_ROW + fq * 32 + 16);
}

struct EpiInProj {
    static constexpr bool PERM = true, ASIG = false, HAS_PRE = true; static constexpr int BMODE = 1;
    __device__ __forceinline__ void pre(PG8_LAS unsigned char*, const pg8::Unit&, int, int, int) const {}
    bf16_t* base; const float* qg; const float* kg; float* KM;
    __device__ __forceinline__ void run(const f32x4 (&acc)[2][2][4][2], const pg8::Unit& u, int ui, PG8_LAS unsigned char* lds, int wr, int wc, int fr, int fq) const {
        const int lane = fr + 16 * fq, rt = lane >> 3, ct = lane & 7; PG8_LAS unsigned char* wb = lds + SPARE_ST + (wr * 4 + wc) * ST_WAVE;
        const int gc0 = u.pn * 256, seg = gc0 >> 9;
        bf16_t* O = base + (size_t)seg * ((size_t)SEQ * 512) + (gc0 & 511) + 64 * wc + ct * 8;
        const int row0 = u.pm * 256 + wr * 64 + rt;
        if (seg == 2 || seg == 3) {
            const float* gp = (seg == 2) ? qg : kg; const float sc = (seg == 2) ? C2 : 1.0f;
            f32x4 gv[2][2], cs[2][2];
#pragma unroll
            for (int bj = 0; bj < 2; ++bj)
#pragma unroll
                for (int n = 0; n < 2; ++n) { gv[bj][n] = *(const f32x4*)(gp + 32 * bj + 8 * fq + 4 * n) * sc; cs[bj][n] = (f32x4){0.f, 0.f, 0.f, 0.f}; }
#pragma unroll
            for (int ai = 0; ai < 2; ++ai)
#pragma unroll
                for (int m = 0; m < 4; ++m) {
                    float ss = 0.f;
#pragma unroll
                    for (int bj = 0; bj < 2; ++bj)
#pragma unroll
                        for (int n = 0; n < 2; ++n) { const f32x4 x = acc[ai][bj][m][n]; ss += (x[0] * x[0] + x[1] * x[1]) + (x[2] * x[2] + x[3] * x[3]); }
                    ss += __shfl_xor(ss, 16); ss += __shfl_xor(ss, 32);
                    const float rstd = rsqrtf(ss * (1.0f / 64.0f) + EPS);
                    bf16_t* rowp = O + (size_t)(row0 + ai * 128 + m * 16) * 512; u32x4 w[2];
#pragma unroll
                    for (int bj = 0; bj < 2; ++bj) { const f32x4 v0 = acc[ai][bj][m][0] * rstd * gv[bj][0], v1 = acc[ai][bj][m][1] * rstd * gv[bj][1];
                        cs[bj][0] += v0; cs[bj][1] += v1;
                        w[bj].x = cvt_pk_bf16(v0[0], v0[1]); w[bj].y = cvt_pk_bf16(v0[2], v0[3]); w[bj].z = cvt_pk_bf16(v1[0], v1[1]); w[bj].w = cvt_pk_bf16(v1[2], v1[3]); }
                    u32x4 r0, r1; st_lane16_to_rows(wb, w[0], w[1], fr, fq, rt, ct, r0, r1); *(u32x4*)rowp = r0; *(u32x4*)(rowp + 8 * 512) = r1;
                }
            if (seg == 3) {
                float* kmp = KM + ((size_t)((u.pm >> 4) * NH + (u.pn & 1) * 4 + wc) * 16 + (u.pm & 15)) * 64 + 8 * fq;
#pragma unroll
                for (int bj = 0; bj < 2; ++bj)
#pragma unroll
                    for (int n = 0; n < 2; ++n)
#pragma unroll
                        for (int e = 0; e < 4; ++e) { float s = cs[bj][n][e]; s += __shfl_xor(s, 1); s += __shfl_xor(s, 2); s += __shfl_xor(s, 4); s += __shfl_xor(s, 8);
                            if (fr == 0) atomicAdd(kmp + 32 * bj + 4 * n + e, s * (1.0f / 256.0f)); }
            }
        } else {
#pragma unroll
            for (int ai = 0; ai < 2; ++ai)
#pragma unroll
                for (int m = 0; m < 4; ++m) { bf16_t* rowp = O + (size_t)(row0 + ai * 128 + m * 16) * 512; u32x4 w[2];
#pragma unroll
                    for (int bj = 0; bj < 2; ++bj) { const f32x4 v0 = acc[ai][bj][m][0], v1 = acc[ai][bj][m][1];
                        w[bj].x = cvt_pk_bf16(v0[0], v0[1]); w[bj].y = cvt_pk_bf16(v0[2], v0[3]); w[bj].z = cvt_pk_bf16(v1[0], v1[1]); w[bj].w = cvt_pk_bf16(v1[2], v1[3]); }
                    u32x4 r0, r1; st_lane16_to_rows(wb, w[0], w[1], fr, fq, rt, ct, r0, r1); *(u32x4*)rowp = r0; *(u32x4*)(rowp + 8 * 512) = r1; }
        }
    }
};
#define NT_LD(p) __builtin_nontemporal_load((const u32x4*)(p))
#define NT_ST(p, v) __builtin_nontemporal_store((v), (u32x4*)(p))
struct EpiBf16Plain {
    static constexpr bool PERM = true, ASIG = false, HAS_PRE = true; static constexpr int BMODE = 1;
    bf16_t* O; long pad_;
    static constexpr int ldc = DM;
    __device__ __forceinline__ void pre(PG8_LAS unsigned char*, const pg8::Unit&, int, int, int) const {}
    __device__ __forceinline__ void run(const f32x4 (&acc)[2][2][4][2], const pg8::Unit& u, int ui, PG8_LAS unsigned char* lds, int wr, int wc, int fr, int fq) const {
        int lane; asm volatile("v_mbcnt_lo_u32_b32 %0, -1, 0\n\tv_mbcnt_hi_u32_b32 %0, -1, %0" : "=&v"(lane));
        const int rt = lane >> 3, ct = lane & 7; PG8_LAS unsigned char* wb = lds + SPARE_ST + (wr * 4 + wc) * ST_WAVE;
        const int ob = (u.pm * 256 + wr * 64 + rt) * ldc + u.pn * 256 + 64 * wc + ct * 8;
#pragma unroll
        for (int ai = 0; ai < 2; ++ai)
#pragma unroll
            for (int m = 0; m < 4; ++m) { u32x4 w[2];
#pragma unroll
                for (int bj = 0; bj < 2; ++bj) { const f32x4 v0 = acc[ai][bj][m][0], v1 = acc[ai][bj][m][1];
                    w[bj].x = cvt_pk_bf16(v0[0], v0[1]); w[bj].y = cvt_pk_bf16(v0[2], v0[3]); w[bj].z = cvt_pk_bf16(v1[0], v1[1]); w[bj].w = cvt_pk_bf16(v1[2], v1[3]); }
                u32x4 r0, r1; st_lane16_to_rows(wb, w[0], w[1], fr, fq, rt, ct, r0, r1);
                bf16_t* rowp = O + (ob + (ai * 128 + m * 16) * ldc); NT_ST(rowp, r0); NT_ST(rowp + 8 * ldc, r1); }
    }
};
template <int BASE> struct EpiResid {
    static constexpr bool PERM = true, ASIG = false, HAS_PRE = true, BASE_BF16 = (BASE != 0); static constexpr int BMODE = 1;
    const void* basev; bf16_t* xb; float* ss; const float* rinv; const float* gmix;
    __device__ __forceinline__ void pre(PG8_LAS unsigned char*, const pg8::Unit&, int, int, int) const {}
    __device__ __forceinline__ void run(const f32x4 (&acc)[2][2][4][2], const pg8::Unit& u, int ui, PG8_LAS unsigned char* lds, int wr, int wc, int fr, int fq) const {
        const int lane = fr + 16 * fq, rt = lane >> 3, ct = lane & 7;
        PG8_LAS unsigned char* wb = lds + SPARE_ST + (wr * 4 + wc) * ST_WAVE;
        const int rows0 = u.pm * 256 + wr * 64, cols0 = u.pn * 256 + 64 * wc;
        constexpr int DEPTH = BASE_BF16 ? 4 : 2, NR = BASE_BF16 ? 2 : 4;
        u32x4 X[DEPTH][NR];
#define ER_LOAD(slot, g) do { const size_t r_ = (size_t)(rows0 + ((g) >> 2) * 128 + ((g) & 3) * 16 + rt) * DM + cols0; \
        if constexpr (BASE_BF16) { X[slot][0] = NT_LD((const bf16_t*)basev + r_ + ct * 8); X[slot][1] = NT_LD((const bf16_t*)basev + r_ + 8 * DM + ct * 8); } \
        else { X[slot][0] = NT_LD((const float*)basev + r_ + ct * 4); X[slot][1] = NT_LD((const float*)basev + r_ + 8 * DM + ct * 4); \
               X[slot][2] = NT_LD((const float*)basev + r_ + 32 + ct * 4); X[slot][3] = NT_LD((const float*)basev + r_ + 8 * DM + 32 + ct * 4); } } while (0)
#pragma unroll
        for (int g = 0; g < DEPTH; ++g) ER_LOAD(g, g);
        float ri[8]; f32x4 gi[2][2];
        if constexpr (BASE == 2) {
#pragma unroll
            for (int g = 0; g < 8; ++g) ri[g] = rinv[rows0 + (g >> 2) * 128 + (g & 3) * 16 + fr];
#pragma unroll
            for (int bj = 0; bj < 2; ++bj)
#pragma unroll
                for (int n = 0; n < 2; ++n) { const f32x4 gg = *(const f32x4*)(gmix + cols0 + 32 * bj + 8 * fq + 4 * n);
                    gi[bj][n] = (f32x4){__builtin_amdgcn_rcpf(gg[0]), __builtin_amdgcn_rcpf(gg[1]), __builtin_amdgcn_rcpf(gg[2]), __builtin_amdgcn_rcpf(gg[3])}; } }
#pragma unroll
        for (int g = 0; g < 8; ++g) { const int ai = g >> 2, m = g & 3; float s = 0.f;
            f32x4 bs[2][2];
            if constexpr (BASE_BF16) { u32x4 p0, p1; st_rows_to_lane16(wb, X[g % DEPTH][0], X[g % DEPTH][1], fr, fq, rt, ct, p0, p1);
                bs[0][0] = (f32x4){bf2f(p0.x & 0xffffu), bf2f(p0.x >> 16), bf2f(p0.y & 0xffffu), bf2f(p0.y >> 16)}; bs[0][1] = (f32x4){bf2f(p0.z & 0xffffu), bf2f(p0.z >> 16), bf2f(p0.w & 0xffffu), bf2f(p0.w >> 16)};
                bs[1][0] = (f32x4){bf2f(p1.x & 0xffffu), bf2f(p1.x >> 16), bf2f(p1.y & 0xffffu), bf2f(p1.y >> 16)}; bs[1][1] = (f32x4){bf2f(p1.z & 0xffffu), bf2f(p1.z >> 16), bf2f(p1.w & 0xffffu), bf2f(p1.w >> 16)}; }
            else {
#pragma unroll
                for (int bj = 0; bj < 2; ++bj) { u32x4 p0, p1; st_rows_to_lane32(wb, X[g % DEPTH][2 * bj], X[g % DEPTH][2 * bj + 1], fr, fq, rt, ct, p0, p1);
                    bs[bj][0] = __builtin_bit_cast(f32x4, p0); bs[bj][1] = __builtin_bit_cast(f32x4, p1); } }
            if (g + DEPTH < 8) ER_LOAD(g % DEPTH, g + DEPTH);
            if constexpr (BASE == 2) {
#pragma unroll
                for (int bj = 0; bj < 2; ++bj)
#pragma unroll
                    for (int n = 0; n < 2; ++n) bs[bj][n] = bs[bj][n] * gi[bj][n] * ri[g]; }
            u32x4 pc[2];
#pragma unroll
            for (int bj = 0; bj < 2; ++bj) { const f32x4 o0 = bs[bj][0] + acc[ai][bj][m][0], o1 = bs[bj][1] + acc[ai][bj][m][1];
                s += ((o0[0] * o0[0] + o0[1] * o0[1]) + (o0[2] * o0[2] + o0[3] * o0[3])) + ((o1[0] * o1[0] + o1[1] * o1[1]) + (o1[2] * o1[2] + o1[3] * o1[3]));
                pc[bj].x = cvt_pk_bf16(o0[0], o0[1]); pc[bj].y = cvt_pk_bf16(o0[2], o0[3]); pc[bj].z = cvt_pk_bf16(o1[0], o1[1]); pc[bj].w = cvt_pk_bf16(o1[2], o1[3]); }
            u32x4 r0, r1; st_lane16_to_rows(wb, pc[0], pc[1], fr, fq, rt, ct, r0, r1);
            bf16_t* op = xb + (size_t)(rows0 + ai * 128 + m * 16 + rt) * DM + cols0 + ct * 8;
            *(u32x4*)op = r0; *(u32x4*)(op + 8 * DM) = r1;
            s += __shfl_xor(s, 16); s += __shfl_xor(s, 32);
            if (fq == 0) ss[(size_t)(rows0 + ai * 128 + m * 16 + fr) * 16 + u.pn * 4 + wc] = s; }
#undef ER_LOAD
    }
};
__device__ __forceinline__ f32x4 ss_part(const float* ss, int row, int fq) { return *(const f32x4*)(ss + (size_t)row * 16 + 4 * fq); }
__device__ __forceinline__ float rstd_from(f32x4 p) { float s = (p[0] + p[1]) + (p[2] + p[3]); s += __shfl_xor(s, 16); s += __shfl_xor(s, 32); return rsqrtf(s * (1.0f / DM) + EPS); }
__device__ __forceinline__ float row_rstd(const float* ss, int row, int fq) {
    const f32x4 p = *(const f32x4*)(ss + (size_t)row * 16 + 4 * fq); float s = (p[0] + p[1]) + (p[2] + p[3]);
    s += __shfl_xor(s, 16); s += __shfl_xor(s, 32); return rsqrtf(s * (1.0f / DM) + EPS);
}
__device__ __forceinline__ float dpp_shr1(float old, float v) { return __builtin_bit_cast(float, __builtin_amdgcn_update_dpp(__builtin_bit_cast(int, old), __builtin_bit_cast(int, v), 0x111, 0xf, 0xf, false)); }
__device__ __forceinline__ float dpp_ror1(float v) { return __builtin_bit_cast(float, __builtin_amdgcn_update_dpp(__builtin_bit_cast(int, v), __builtin_bit_cast(int, v), 0x121, 0xf, 0xf, false)); }
struct EpiUpFused {
    static constexpr bool PERM = true, ASIG = true, HAS_PRE = true; static constexpr int BMODE = 2;
    bf16_t* ACT; const float* cw; const float* cb; float* GT; float* PART; float* VH; const float* ssg; int pm0, pm1;
    __device__ __forceinline__ void pre(PG8_LAS unsigned char* lds, const pg8::Unit& u, int ui, int wid, int lane) const {
        if (wid < 2) { const int idx = 4 * (64 * wid + lane), arr = idx >> 7, col = idx & 127; const float* src_ = (arr < 3 ? cw + (size_t)arr * DFF : cb) + u.pn * 128 + col;
            __builtin_amdgcn_global_load_lds((const unsigned*)src_, (PG8_LAS unsigned*)(lds + SPARE_CW + (ui & 1) * 2048 + wid * 1024), 16, 0, 0); }
    }
    __device__ __forceinline__ void run(const f32x4 (&acc)[2][2][4][2], const pg8::Unit& u, int ui, PG8_LAS unsigned char* lds, int wr, int wc, int fr, int fq) const {
        const int j0 = u.pn * 128 + wc * 32 + 8 * fq, rbase = u.pm * 256 + 128 * wr + 8 * fr, strip = u.pm * 2 + wr;
        float rs[8];
        if (pm1 >= 0) { const PG8_LAS f32x4* rp = (const PG8_LAS f32x4*)(lds + SPARE_RS + (u.pm == pm0 ? 0 : 1024) + (128 * wr + 8 * fr) * 4); const f32x4 r0 = rp[0], r1 = rp[1];
          rs[0] = r0[0]; rs[1] = r0[1]; rs[2] = r0[2]; rs[3] = r0[3]; rs[4] = r1[0]; rs[5] = r1[1]; rs[6] = r1[2]; rs[7] = r1[3]; }
        else {
#pragma unroll
            for (int s = 0; s < 8; ++s) rs[s] = rstd_from(ss_part(ssg, rbase + s, fq)); }
        f32x2 w0[4], w1[4], w2[4], bb[4], pm1[4], pm2[4];
        { const PG8_LAS f32x4* wp = (const PG8_LAS f32x4*)(lds + SPARE_CW + (ui & 1) * 2048 + (wc * 32 + 8 * fq) * 4);
          const f32x4 a0 = wp[0], a1 = wp[1], b0 = wp[32], b1 = wp[33], c0 = wp[64], c1 = wp[65], d0 = wp[96], d1 = wp[97];
          w0[0] = (f32x2){a0[0], a0[1]}; w0[1] = (f32x2){a0[2], a0[3]}; w0[2] = (f32x2){a1[0], a1[1]}; w0[3] = (f32x2){a1[2], a1[3]};
          w1[0] = (f32x2){b0[0], b0[1]}; w1[1] = (f32x2){b0[2], b0[3]}; w1[2] = (f32x2){b1[0], b1[1]}; w1[3] = (f32x2){b1[2], b1[3]};
          w2[0] = (f32x2){c0[0], c0[1]}; w2[1] = (f32x2){c0[2], c0[3]}; w2[2] = (f32x2){c1[0], c1[1]}; w2[3] = (f32x2){c1[2], c1[3]};
          bb[0] = (f32x2){d0[0], d0[1]}; bb[1] = (f32x2){d0[2], d0[3]}; bb[2] = (f32x2){d1[0], d1[1]}; bb[3] = (f32x2){d1[2], d1[3]}; }
#pragma unroll
        for (int q = 0; q < 4; ++q) { const int n = q >> 1, h = q & 1;
            const f32x2 g6 = (f32x2){acc[1][0][2][n][2 * h], acc[1][0][2][n][2 * h + 1]} * rs[6], g7 = (f32x2){acc[1][0][3][n][2 * h], acc[1][0][3][n][2 * h + 1]} * rs[7];
            pm2[q].x = dpp_shr1(0.f, g6.x); pm2[q].y = dpp_shr1(0.f, g6.y); pm1[q].x = dpp_shr1(0.f, g7.x); pm1[q].y = dpp_shr1(0.f, g7.y); }
#pragma unroll
        for (int s = 0; s < 8; ++s) { const int ai = s >> 2, m = s & 3, row = rbase + s; const float rstd = rs[s];
            f32x2 a[4];
#pragma unroll
            for (int q = 0; q < 4; ++q) { const int n = q >> 1, h = q & 1;
                const f32x2 g = (f32x2){acc[ai][0][m][n][2 * h], acc[ai][0][m][n][2 * h + 1]} * rstd, v = (f32x2){acc[ai][1][m][n][2 * h], acc[ai][1][m][n][2 * h + 1]} * rstd;
                const f32x2 pre = w0[q] * pm2[q] + (w1[q] * pm1[q] + (w2[q] * g + bb[q]));
                pm2[q] = pm1[q]; pm1[q] = g;
                const f32x2 t = pre * pre, uu = t * (-0.0713548163f * LOG2E) + (-1.5957691216f * LOG2E), z = pre * uu;
                f32x2 ee; ee.x = __builtin_amdgcn_exp2f(z.x); ee.y = __builtin_amdgcn_exp2f(z.y);
                const f32x2 dd = ee + 1.0f; f32x2 rr; rr.x = __builtin_amdgcn_rcpf(dd.x); rr.y = __builtin_amdgcn_rcpf(dd.y);
                a[q] = (pre * rr) * v;
                if (s < 2 && fr == 0) { *(f32x2*)(PART + ((size_t)strip * 2 + s) * DFF + j0 + 2 * q) = pre; *(f32x2*)(VH + ((size_t)strip * 2 + s) * DFF + j0 + 2 * q) = v; }
                if (s >= 6 && fr == 15) *(f32x2*)(GT + ((size_t)strip * 2 + (s - 6)) * DFF + j0 + 2 * q) = g; }
            u32x4 w; w.x = cvt_pk_bf16(a[0].x, a[0].y); w.y = cvt_pk_bf16(a[1].x, a[1].y); w.z = cvt_pk_bf16(a[2].x, a[2].y); w.w = cvt_pk_bf16(a[3].x, a[3].y);
            *(u32x4*)(ACT + (size_t)row * DFF + j0) = w; }
    }
};
struct EpiFinal {
    static constexpr bool PERM = true, ASIG = false, HAS_PRE = true; static constexpr int BMODE = 1;
    float* out; const bf16_t* h2b; const bf16_t* prj; const float* ss;
    __device__ __forceinline__ void pre(PG8_LAS unsigned char*, const pg8::Unit&, int, int, int) const {}
    __device__ __forceinline__ void run(const f32x4 (&acc)[2][2][4][2], const pg8::Unit& u, int ui, PG8_LAS unsigned char* lds, int wr, int wc, int fr, int fq) const {
        const int lane = fr + 16 * fq, rt = lane >> 3, ct = lane & 7;
        PG8_LAS unsigned char* wb = lds + SPARE_ST + (wr * 4 + wc) * ST_WAVE;
        const int rows0 = u.pm * 256 + wr * 64, cols0 = u.pn * 256 + 64 * wc;
        float rs[8];
        { f32x4 sp[8];
#pragma unroll
          for (int g = 0; g < 8; ++g) sp[g] = ss_part(ss, rows0 + (g >> 2) * 128 + (g & 3) * 16 + fr, fq);
#pragma unroll
          for (int g = 0; g < 8; ++g) rs[g] = rstd_from(sp[g]); }
        constexpr int DEPTH = 3;
        u32x4 H[DEPTH][2], P[DEPTH][2];
#define EF_LOAD(slot, g) do { const size_t o_ = (size_t)(rows0 + ((g) >> 2) * 128 + ((g) & 3) * 16 + rt) * DM + cols0 + ct * 8; \
        H[slot][0] = NT_LD(h2b + o_); H[slot][1] = NT_LD(h2b + o_ + 8 * DM); P[slot][0] = NT_LD(prj + o_); P[slot][1] = NT_LD(prj + o_ + 8 * DM); } while (0)
#pragma unroll
        for (int g = 0; g < DEPTH; ++g) EF_LOAD(g, g);
#pragma unroll
        for (int g = 0; g < 8; ++g) { const int ai = g >> 2, m = g & 3; const float rstd = rs[g];
            u32x4 hv[2], pv[2];
            *(PG8_LAS u32x4*)(wb + rt * ST_ROW + ct * 16) = H[g % DEPTH][0]; *(PG8_LAS u32x4*)(wb + (rt + 8) * ST_ROW + ct * 16) = H[g % DEPTH][1];
            hv[0] = *(const PG8_LAS u32x4*)(wb + fr * ST_ROW + fq * 16); hv[1] = *(const PG8_LAS u32x4*)(wb + fr * ST_ROW + 64 + fq * 16);
            *(PG8_LAS u32x4*)(wb + rt * ST_ROW + ct * 16) = P[g % DEPTH][0]; *(PG8_LAS u32x4*)(wb + (rt + 8) * ST_ROW + ct * 16) = P[g % DEPTH][1];
            pv[0] = *(const PG8_LAS u32x4*)(wb + fr * ST_ROW + fq * 16); pv[1] = *(const PG8_LAS u32x4*)(wb + fr * ST_ROW + 64 + fq * 16);
            if (g + DEPTH < 8) EF_LOAD(g % DEPTH, g + DEPTH);
#pragma unroll
            for (int bj = 0; bj < 2; ++bj) { f32x4 o[2];
#pragma unroll
                for (int n = 0; n < 2; ++n) { const f32x4 a = acc[ai][bj][m][n] * rstd; const unsigned h0 = hv[bj][2 * n], h1 = hv[bj][2 * n + 1], p0 = pv[bj][2 * n], p1 = pv[bj][2 * n + 1];
                    o[n][0] = bf2f(h0 & 0xffffu) + sigmoidf_(a[0]) * bf2f(p0 & 0xffffu); o[n][1] = bf2f(h0 >> 16) + sigmoidf_(a[1]) * bf2f(p0 >> 16);
                    o[n][2] = bf2f(h1 & 0xffffu) + sigmoidf_(a[2]) * bf2f(p1 & 0xffffu); o[n][3] = bf2f(h1 >> 16) + sigmoidf_(a[3]) * bf2f(p1 >> 16); }
                *(PG8_LAS u32x4*)(wb + fr * ST_ROW + fq * 32) = __builtin_bit_cast(u32x4, o[0]); *(PG8_LAS u32x4*)(wb + fr * ST_ROW + fq * 32 + 16) = __builtin_bit_cast(u32x4, o[1]);
                const u32x4 r0 = *(const PG8_LAS u32x4*)(wb + rt * ST_ROW + ct * 16), r1 = *(const PG8_LAS u32x4*)(wb + (rt + 8) * ST_ROW + ct * 16);
                float* op = out + (size_t)(rows0 + ai * 128 + m * 16 + rt) * DM + cols0 + 32 * bj + ct * 4;
                NT_ST(op, r0); NT_ST(op + 8 * DM, r1); } }
#undef EF_LOAD
    }
};

#define GAS __attribute__((address_space(1)))
#define LAS __attribute__((address_space(3)))
typedef float f32x16 __attribute__((ext_vector_type(16)));
#define LDS_WAIT() asm volatile("s_waitcnt lgkmcnt(0)" ::: "memory")
#define VM_WAIT() asm volatile("s_waitcnt vmcnt(0)" ::: "memory")
constexpr int NWAVES = 8;
constexpr int RING_BYTES = 131072, MISC_OFF = RING_BYTES + 320, LDS_BYTES = 163840;

#define XB_TMO      128
#define XB_XCNT(j)  (256  + 64 * (j))
#define XB_XSUB(j)  (1280 + 64 * (j))
#define XB_XGEN(j)  (2304 + 64 * (j))
#define XB_TOP      3328
#define XB_TOPGEN   3392
#define XCD_BAR_WORDS 3456
#define XB_SPIN_CAP (1u << 20)
__device__ __forceinline__ unsigned xb_ld(unsigned* p)              { return __hip_atomic_load(p, __ATOMIC_RELAXED, __HIP_MEMORY_SCOPE_AGENT); }
__device__ __forceinline__ unsigned xb_add(unsigned* p, unsigned v) { return __hip_atomic_fetch_add(p, v, __ATOMIC_RELAXED, __HIP_MEMORY_SCOPE_AGENT); }
__device__ __forceinline__ unsigned xb_xcc_id() { return (unsigned)__builtin_amdgcn_s_getreg((3 << 11) | 20) & 0xFu; }
#define XB_SPIN(cond, bar) do { unsigned _sp = 0; while (cond) { __builtin_amdgcn_s_sleep(1); \
    if ((++_sp & 255u) == 0u) { if (xb_ld(&(bar)[XB_TMO])) break; if (_sp > XB_SPIN_CAP) { atomicAdd(&(bar)[XB_TMO], 1u); break; } } } } while (0)
struct XcdBarrier { unsigned* bar; unsigned x; volatile LAS unsigned* st; };
__device__ __forceinline__ XcdBarrier xcd_barrier_post(unsigned* bar, volatile LAS unsigned* st) {
    XcdBarrier b; b.bar = bar; b.x = xb_xcc_id(); b.st = st;
    if (threadIdx.x == 0) { (void)xb_add(&bar[XB_XCNT(b.x)], 1u); __hip_atomic_store(&bar[10240   + blockIdx.x], b.x + 1u, __ATOMIC_RELAXED, __HIP_MEMORY_SCOPE_AGENT); }
    return b;
}
__device__ __forceinline__ void xcd_barrier_complete(unsigned* bar, unsigned x, unsigned& nloc, unsigned& nx) {
    const unsigned G = gridDim.x * gridDim.y * gridDim.z;
    unsigned sum, cnt, mine, sp = 0u;
    for (;;) {
        sum = 0u; cnt = 0u; mine = 0u;
#pragma unroll
        for (unsigned j = 0; j < 16; ++j) { const unsigned c = xb_ld(&bar[XB_XCNT(j)]); sum += c; cnt += (c > 0u) ? 1u : 0u; mine = (j == x) ? c : mine; }
        if (sum == G) break;
        __builtin_amdgcn_s_sleep(1);
        if ((++sp & 255u) == 0u) { if (xb_ld(&bar[XB_TMO])) break; if (sp > XB_SPIN_CAP) { atomicAdd(&bar[XB_TMO], 1u); break; } }
    }
    nloc = mine > 0u ? mine : 1u; nx = cnt > 0u ? cnt : 1u;
}
__device__ __forceinline__ void xcd_barrier(const XcdBarrier& b) {
    asm volatile("s_waitcnt vmcnt(0)" ::: "memory");
    __syncthreads();
    if (threadIdx.x == 0) {
        unsigned* bar = b.bar;
        __builtin_amdgcn_s_waitcnt(0);
        unsigned nloc = b.st[0], nx = b.st[1];
        if (nloc == 0u) { xcd_barrier_complete(bar, b.x, nloc, nx); b.st[0] = nloc; b.st[1] = nx; }
        const unsigned old = xb_add(&bar[XB_XSUB(b.x)], 1u);
        const unsigned gen = old / nloc;
        if (old + 1u == (gen + 1u) * nloc) {
            __builtin_amdgcn_fence(__ATOMIC_RELEASE, "agent");
            asm volatile("s_waitcnt vmcnt(0)" ::: "memory");
            const unsigned og = xb_add(&bar[XB_TOP], 1u);
            const unsigned tg = og / nx;
            if (og + 1u == (tg + 1u) * nx) xb_add(&bar[XB_TOPGEN], 1u);
            else XB_SPIN(xb_ld(&bar[XB_TOPGEN]) == tg, bar);
            __builtin_amdgcn_fence(__ATOMIC_ACQUIRE, "agent");
            xb_add(&bar[XB_XGEN(b.x)], 1u);
            asm volatile("s_waitcnt vmcnt(0)" ::: "memory");
        } else {
            XB_SPIN(xb_ld(&bar[XB_XGEN(b.x)]) == gen, bar);
            __builtin_amdgcn_fence(__ATOMIC_ACQUIRE, "agent");
            asm volatile("s_waitcnt vmcnt(0)" ::: "memory");
        }
    }
    __syncthreads();
}

#define GB_SUB(r) (9216 + 64 * (r))
#define GB_GEN(r) (9728 + 64 * (r))
#define GB_XID    10240
#define GB_WCNT   10752
struct GrpBarV { unsigned* bar; unsigned r, n, fast; };
__device__ __forceinline__ void grp_barrier(unsigned* bar_, volatile LAS unsigned* fastp) {
    asm volatile("s_waitcnt vmcnt(0)" ::: "memory");
    __syncthreads();
    if (threadIdx.x == 0) {
        GrpBarV g{bar_, blockIdx.x & 7u, gridDim.x >> 3, *fastp};
        unsigned* bar = g.bar;
        if (g.fast == 0u) {
            const unsigned me = xb_ld(&bar[GB_XID + blockIdx.x]); bool ok = (me != 0u);
            for (unsigned i = g.r; i < gridDim.x; i += 8u) ok = ok && (xb_ld(&bar[GB_XID + i]) == me);
            g.fast = ok ? 1u : 2u; *fastp = g.fast; }
        if (g.fast != 1u) { __builtin_amdgcn_fence(__ATOMIC_RELEASE, "agent"); asm volatile("s_waitcnt vmcnt(0)" ::: "memory"); }
        const unsigned old = xb_add(&bar[GB_SUB(g.r)], 1u);
        const unsigned gen = old / g.n;
        if (old + 1u == (gen + 1u) * g.n) __hip_atomic_store(&bar[GB_GEN(g.r)], gen + 1u, __ATOMIC_RELAXED, __HIP_MEMORY_SCOPE_AGENT);
        else XB_SPIN(xb_ld(&bar[GB_GEN(g.r)]) <= gen, bar);
        __builtin_amdgcn_fence(__ATOMIC_ACQUIRE, "agent");
        asm volatile("s_waitcnt vmcnt(0)" ::: "memory");
    }
    __syncthreads();
}

constexpr size_t MiB = 1u << 20;
constexpr size_t WS_CTL = 0, CTL_ZERO_BYTES = 64 * 1024;
constexpr size_t WS_RINV0 = 6 * MiB + 512 * 1024;
constexpr size_t WS_KM = 1 * MiB, WS_SS1 = 2 * MiB, WS_SS2 = 4 * MiB, WS_GW = 6 * MiB  , WS_SUMM = 7 * MiB  ;
constexpr size_t WS_WIN = 8 * MiB, WS_WOUT = 13 * MiB, WS_WUP = 15 * MiB, WS_WDN = 27 * MiB, WS_WG = 33 * MiB, WS_WP = 35 * MiB;
constexpr size_t WS_XN = 40 * MiB;
constexpr size_t WS_PB = 104 * MiB;
constexpr size_t WS_PRJ = 120 * MiB;
constexpr size_t WS_R = 184 * MiB, SLAB = 32 * MiB;
constexpr size_t WS_GT = 480 * MiB, WS_PART = 488 * MiB, WS_VH = 496 * MiB;
constexpr size_t WS_END = 512 * MiB;

struct Args { const float* in[22]; float* out; unsigned char* ws; int ph_lo, ph_hi; };
struct Frame {
    LAS unsigned char* lds; int tid, lane, wave, vcu, G;
};
__device__ __forceinline__ float wave_sum(float v) {
#pragma unroll
    for (int o = 1; o < 64; o <<= 1) v += __shfl_xor(v, o);
    return v;
}
__device__ __forceinline__ float wave_max(float v) {
#pragma unroll
    for (int o = 1; o < 64; o <<= 1) v = fmaxf(v, __shfl_xor(v, o));
    return v;
}
__device__ __forceinline__ void p0_transpose_item(const float* W, int ldw, int N, bf16_t* WT, int ldt, const float* gain, LAS float* scr, int item, int lane) {
    const int nblk = N / 32, kb = item / nblk, nb = item % nblk, k0 = 64 * kb, n0 = 32 * nb;
#pragma unroll
    for (int i = 0; i < 32; ++i) { const int kk = 2 * i + (lane >> 5); scr[kk * 33 + (lane & 31)] = __builtin_nontemporal_load(W + (size_t)(k0 + kk) * ldw + n0 + (lane & 31)) * (gain ? gain[k0 + kk] : 1.0f); }
    LDS_WAIT(); asm volatile("" ::: "memory");
    const int c = lane & 7;
#pragma unroll
    for (int j = 0; j < 4; ++j) { const int n = (lane >> 3) + 8 * j; const LAS float* s = scr + (8 * c) * 33 + n;
        u32x4 o; o.x = pk2(s[0 * 33], s[1 * 33]); o.y = pk2(s[2 * 33], s[3 * 33]); o.z = pk2(s[4 * 33], s[5 * 33]); o.w = pk2(s[6 * 33], s[7 * 33]);
        asm volatile("global_store_dwordx4 %0, %1, off sc0 sc1" :: "v"(WT + (size_t)(n0 + n) * ldt + k0 + 8 * c), "v"(o) : "memory"); }
    LDS_WAIT(); asm volatile("" ::: "memory");
}
__device__ __forceinline__ int crow16(int r, int hi) { return (r & 3) + 8 * (r >> 2) + 4 * hi; }
struct LruP { const bf16_t* __restrict__ XL; const bf16_t* __restrict__ GL; const float* __restrict__ cw; const float* __restrict__ cb; const bf16_t* __restrict__ WaT; const bf16_t* __restrict__ WxT;
              const float* __restrict__ ba; const float* __restrict__ bx; const float* __restrict__ lam; f32x2* SUMM; bf16_t* __restrict__ Y; unsigned* __restrict__ LAB; };
__device__ __forceinline__ void lru_scan_groups(const float (&av)[16], const float (&bv)[16], int hi, float (&sA)[8], float (&sB)[8], float& Aw, float& Bw) {
    float Ag[4], Bg[4];
#pragma unroll
    for (int gq = 0; gq < 4; ++gq) { const float a0 = av[4 * gq], a1 = av[4 * gq + 1], a2 = av[4 * gq + 2], a3 = av[4 * gq + 3];
        const float b0 = bv[4 * gq], b1 = bv[4 * gq + 1], b2 = bv[4 * gq + 2], b3 = bv[4 * gq + 3];
        Ag[gq] = (a0 * a1) * (a2 * a3); Bg[gq] = ((b0 * a1 + b1) * a2 + b2) * a3 + b3; }
    Aw = 1.f; Bw = 0.f;
#pragma unroll
    for (int gq = 0; gq < 4; ++gq) { const float oA = __shfl_xor(Ag[gq], 32), oB = __shfl_xor(Bg[gq], 32);
        sA[2 * gq] = hi ? oA : Ag[gq]; sB[2 * gq] = hi ? oB : Bg[gq]; sA[2 * gq + 1] = hi ? Ag[gq] : oA; sB[2 * gq + 1] = hi ? Bg[gq] : oB; }
#pragma unroll
    for (int G = 0; G < 8; ++G) { Bw = sA[G] * Bw + sB[G]; Aw *= sA[G]; }
}
constexpr int LR_XT = 4096, LR_CARRY = LR_XT + 8 * 40 * 144, LR_WA = LR_CARRY + 256, LR_WX = LR_WA + 64 * 144, LR_CW = LR_WX + 64 * 144, LR_CB = LR_CW + 1024, LR_BA = LR_CB + 256, LR_BX = LR_BA + 256, LR_SP = LR_BX + 256;
__device__ __forceinline__ void lru_setup(const LruP& P, LAS unsigned char* lds, int n, int tid) {
    { const int d = tid >> 3, ch = tid & 7;
      *(LAS u32x4*)(lds + LR_WA + d * 144 + ch * 16) = *(const u32x4*)(P.WaT + ((size_t)(n * 64 + d)) * 64 + ch * 8);
      *(LAS u32x4*)(lds + LR_WX + d * 144 + ch * 16) = *(const u32x4*)(P.WxT + ((size_t)(n * 64 + d)) * 64 + ch * 8); }
    if (tid < 256) ((LAS float*)(lds + LR_CW))[tid] = P.cw[(tid >> 6) * LRU_W + n * 64 + (tid & 63)];
    if (tid < 64) { const int ch = n * 64 + tid; ((LAS float*)(lds + LR_CB))[tid] = P.cb[ch]; ((LAS float*)(lds + LR_BA))[tid] = P.ba[ch]; ((LAS float*)(lds + LR_BX))[tid] = P.bx[ch];
        ((LAS float*)(lds + LR_SP))[tid] = -8.0f * LOG2E * log1pf(__expf(-P.lam[ch])); }
    LDS_WAIT(); __syncthreads();
}
struct LruTile { u32x4 v[5]; };
__device__ __forceinline__ void lru_tile_load(const LruP& P, LruTile& T, int unit, int wave, int lane) {
    const int c = unit & 15, n = (unit >> 4) & 7, b = unit >> 7, t0 = c * 256 + wave * 32, rt = lane >> 3, ct = lane & 7;
#pragma unroll
    for (int p = 0; p < 5; ++p) { const int tr = t0 - 3 + 8 * p + rt; T.v[p] = (u32x4){0u, 0u, 0u, 0u};
        if (tr >= 0 && tr < SEQ) T.v[p] = NT_LD(P.XL + ((size_t)b * SEQ + tr) * 512 + n * 64 + ct * 8); }
}
__device__ __forceinline__ void lru_unit_fused(const LruP& P, LAS unsigned char* lds, unsigned* cnt, LruTile& T, int unit, int next_unit, int wave, int lane) {
    const int c = unit & 15, n = (unit >> 4) & 7, b = unit >> 7, r32 = lane & 31, hi = lane >> 5;
    const int t0 = c * 256 + wave * 32; const size_t m0 = (size_t)b * SEQ + t0;
    LAS unsigned char* xt = lds + LR_XT + wave * (40 * 144);
    { const int rt = lane >> 3, ct = lane & 7;
#pragma unroll
      for (int p = 0; p < 5; ++p) *(LAS u32x4*)(xt + (8 * p + rt) * 144 + ct * 16) = T.v[p]; }
    bf16x8 afr[4];
#pragma unroll
    for (int ks = 0; ks < 4; ++ks) { const int cl = 16 * ks + 8 * hi;
        f32x4 x0 = *(const LAS f32x4*)(lds + LR_CB + cl * 4), x1 = *(const LAS f32x4*)(lds + LR_CB + cl * 4 + 16);
#pragma unroll
        for (int k = 0; k < 4; ++k) { const u32x4 w = *(const LAS u32x4*)(xt + (r32 + k) * 144 + (2 * ks + hi) * 16);
            const f32x4 c0 = *(const LAS f32x4*)(lds + LR_CW + (k * 64 + cl) * 4), c1 = *(const LAS f32x4*)(lds + LR_CW + (k * 64 + cl) * 4 + 16);
            x0[0] += c0[0] * bf2f(w.x & 0xffffu); x0[1] += c0[1] * bf2f(w.x >> 16); x0[2] += c0[2] * bf2f(w.y & 0xffffu); x0[3] += c0[3] * bf2f(w.y >> 16);
            x1[0] += c1[0] * bf2f(w.z & 0xffffu); x1[1] += c1[1] * bf2f(w.z >> 16); x1[2] += c1[2] * bf2f(w.w & 0xffffu); x1[3] += c1[3] * bf2f(w.w >> 16); }
        u32x4 pw; pw.x = cvt_pk_bf16(x0[0], x0[1]); pw.y = cvt_pk_bf16(x0[2], x0[3]); pw.z = cvt_pk_bf16(x1[0], x1[1]); pw.w = cvt_pk_bf16(x1[2], x1[3]);
        afr[ks] = __builtin_bit_cast(bf16x8, pw); }
    LAS f32x2* WS = (LAS f32x2*)lds;
    float av[2][16], bv[2][16], sA[2][8], sB[2][8];
#pragma unroll
    for (int cbk = 0; cbk < 2; ++cbk) {
        f32x16 racc = f32x16{}, iacc = f32x16{}, xacc = f32x16{};
        bf16x8 wa[4], wx[4];
#pragma unroll
        for (int ks = 0; ks < 4; ++ks) { const int wo = (32 * cbk + r32) * 144 + (16 * ks + 8 * hi) * 2; wa[ks] = *(const LAS bf16x8*)(lds + LR_WA + wo); wx[ks] = *(const LAS bf16x8*)(lds + LR_WX + wo); }
#pragma unroll
        for (int ks = 0; ks < 4; ++ks) {
            bf16x8 idf;
#pragma unroll
            for (int j = 0; j < 8; ++j) idf[j] = ((16 * ks + 8 * hi + j) == (32 * cbk + r32)) ? (short)0x3F80 : (short)0;
            racc = __builtin_amdgcn_mfma_f32_32x32x16_bf16(afr[ks], wa[ks], racc, 0, 0, 0);
            iacc = __builtin_amdgcn_mfma_f32_32x32x16_bf16(afr[ks], wx[ks], iacc, 0, 0, 0);
            xacc = __builtin_amdgcn_mfma_f32_32x32x16_bf16(afr[ks], idf, xacc, 0, 0, 0); }
        const int chl_ = 32 * cbk + r32; const float bav = ((const LAS float*)(lds + LR_BA))[chl_], bxv = ((const LAS float*)(lds + LR_BX))[chl_], sp8 = ((const LAS float*)(lds + LR_SP))[chl_];
#pragma unroll
        for (int r = 0; r < 16; ++r) { const float rr = sigmoidf_(racc[r] + bav), ig = sigmoidf_(iacc[r] + bxv); const float a = __builtin_amdgcn_exp2f(sp8 * rr);
            float mult = __builtin_amdgcn_sqrtf(fmaxf(__builtin_fmaf(-a, a, 1.0f), 0.f)); if (t0 + crow16(r, hi) == 0) mult = 1.0f;
            av[cbk][r] = a; bv[cbk][r] = mult * ig * xacc[r]; }
        float Aw, Bw; lru_scan_groups(av[cbk], bv[cbk], hi, sA[cbk], sB[cbk], Aw, Bw);
        if (hi == 0) WS[wave * 64 + 32 * cbk + r32] = (f32x2){Aw, Bw};
    }
    LDS_WAIT(); __syncthreads();
    if (next_unit >= 0) lru_tile_load(P, T, next_unit, wave, lane);
    unsigned glv[2][8];
#pragma unroll
    for (int cbk = 0; cbk < 2; ++cbk)
#pragma unroll
        for (int r = 0; r < 16; r += 2) glv[cbk][r >> 1] = (unsigned)__builtin_nontemporal_load(P.GL + (m0 + crow16(r, hi)) * 512 + n * 64 + 32 * cbk + r32) | ((unsigned)__builtin_nontemporal_load(P.GL + (m0 + crow16(r + 1, hi)) * 512 + n * 64 + 32 * cbk + r32) << 16);
    unsigned* cp = cnt + 64 * (b * 8 + n);
    if (wave == 0) {
        float A = 1.f, Bv = 0.f;
#pragma unroll
        for (int w = 0; w < 8; ++w) { const f32x2 ab = WS[w * 64 + lane]; Bv = ab[0] * Bv + ab[1]; A *= ab[0]; }
        __hip_atomic_store((unsigned long long*)(P.SUMM + (size_t)unit * 64 + lane), ((unsigned long long)__float_as_uint(Bv) << 32) | __float_as_uint(A), __ATOMIC_RELAXED, __HIP_MEMORY_SCOPE_AGENT);
        asm volatile("s_waitcnt vmcnt(0)" ::: "memory");
        if (lane == 0) __hip_atomic_fetch_or(cp, 1u << c, __ATOMIC_RELAXED, __HIP_MEMORY_SCOPE_AGENT);
        const unsigned need_ = (1u << c) - 1u; unsigned sp_ = 0;
        while (((unsigned)__builtin_amdgcn_readfirstlane(__hip_atomic_load(cp, __ATOMIC_RELAXED, __HIP_MEMORY_SCOPE_AGENT)) & need_) != need_ && ++sp_ < (1u << 22)) __builtin_amdgcn_s_sleep(1);
        float h = 0.f;
#pragma unroll
        for (int c0 = 0; c0 < 16; c0 += 8) { unsigned long long sm[8];
#pragma unroll
          for (int q = 0; q < 8; ++q) { const int cc = c0 + q; sm[q] = __hip_atomic_load((unsigned long long*)(P.SUMM + (size_t)(unit - c + (cc < c ? cc : 0)) * 64 + lane), __ATOMIC_RELAXED, __HIP_MEMORY_SCOPE_AGENT); }
#pragma unroll
          for (int q = 0; q < 8; ++q) { const int cc = c0 + q; const float A_ = (cc < c) ? __uint_as_float((unsigned)sm[q]) : 1.0f, B_ = (cc < c) ? __uint_as_float((unsigned)(sm[q] >> 32)) : 0.0f; h = A_ * h + B_; } }
        ((LAS float*)(lds + LR_CARRY))[lane] = h;
    }
    LDS_WAIT(); __syncthreads();
#pragma unroll
    for (int cbk = 0; cbk < 2; ++cbk) { const int chl = 32 * cbk + r32;
        float h = ((LAS float*)(lds + LR_CARRY))[chl];
#pragma unroll
        for (int w = 0; w < 7; ++w) { const f32x2 ab = WS[w * 64 + chl]; const float A_ = (w < wave) ? ab[0] : 1.0f, B_ = (w < wave) ? ab[1] : 0.0f; h = A_ * h + B_; }
        float Hs[4];
#pragma unroll
        for (int G = 0; G < 8; ++G) { if ((G & 1) == 0) { if (!hi) Hs[G >> 1] = h; } else { if (hi) Hs[G >> 1] = h; } h = sA[cbk][G] * h + sB[cbk][G]; }
        const int ch = n * 64 + chl;
#pragma unroll
        for (int gq = 0; gq < 4; ++gq) { float hh = Hs[gq];
#pragma unroll
            for (int j = 0; j < 4; j += 2) { const int r = 4 * gq + j; const unsigned gw_ = glv[cbk][r >> 1];
                hh = av[cbk][r] * hh + bv[cbk][r]; const float y0 = hh * gelu_tanh(bf2f(gw_ & 0xffffu));
                hh = av[cbk][r + 1] * hh + bv[cbk][r + 1]; const float y1 = hh * gelu_tanh(bf2f(gw_ >> 16));
                const unsigned wy = cvt_pk_bf16(y0, y1);
                P.Y[(m0 + crow16(r, hi)) * DM + ch] = (bf16_t)(wy & 0xffffu); P.Y[(m0 + crow16(r + 1, hi)) * DM + ch] = (bf16_t)(wy >> 16); } }
    }
    __syncthreads();
}

namespace attn {
using bf16x8_t = bf16x8;
typedef short s16x4 __attribute__((ext_vector_type(4)));
constexpr int D = 64, QP = 512  , NW = 8, QBLK = 32, QB = 256, KVBLK = 64;
constexpr int NSLOT = 3, SLOTB = 8192;
constexpr int LDS_K = 0, LDS_V = NSLOT * SLOTB, LDS_WS = 2 * NSLOT * SLOTB, LDS_OST = LDS_WS + NW * 64 * 4, LDS_BYTES_A = LDS_OST + NW * 4096;
#define SBAR() __builtin_amdgcn_sched_barrier(0)
__device__ __forceinline__ int crow(int r, int hi) { return (r & 3) + 8 * (r >> 2) + 4 * hi; }
__device__ __forceinline__ void cmask(f32x16& p0, f32x16& p1, int jb, int qrel, int hi) {
    const float NEG = -INFINITY; const int kb = 64 * jb + 4 * hi;
#pragma unroll
    for (int r = 0; r < 16; ++r) { const int kv = kb + (r & 3) + 8 * (r >> 2); if (kv > qrel) p0[r] = NEG; if (kv + 32 > qrel) p1[r] = NEG; }
}
__device__ __forceinline__ void glds16(const void* gsrc, unsigned lds_dst) { unsigned keep;
    asm volatile("s_mov_b32 %0, m0\n\ts_mov_b32 m0, %2\n\ts_nop 0\n\tglobal_load_lds_dwordx4 %1, off\n\ts_mov_b32 m0, %0" : "=&s"(keep) : "v"(gsrc), "s"(lds_dst) : "memory"); }
typedef float f32x2_t __attribute__((ext_vector_type(2))); typedef __bf16 bf16x2_t __attribute__((ext_vector_type(2)));
__device__ __forceinline__ unsigned cvtpk_s(float lo, float hi) { f32x2_t v = {lo, hi}; bf16x2_t b = __builtin_convertvector(v, bf16x2_t); return __builtin_bit_cast(unsigned, b); }
#define WAIT_BAR(N) asm volatile("s_waitcnt vmcnt(" #N ") lgkmcnt(0)\n\ts_barrier" ::: "memory")
typedef __attribute__((address_space(3))) const char* lds_cptr;
typedef short v4i16_t __attribute__((ext_vector_type(4)));
__device__ __forceinline__ void kload8(bf16x8* kf, lds_cptr kp) {
    kf[0] = *(const __attribute__((address_space(3))) bf16x8*)(kp);        kf[1] = *(const __attribute__((address_space(3))) bf16x8*)(kp + 512);
    kf[2] = *(const __attribute__((address_space(3))) bf16x8*)(kp + 2048); kf[3] = *(const __attribute__((address_space(3))) bf16x8*)(kp + 2560);
    kf[4] = *(const __attribute__((address_space(3))) bf16x8*)(kp + 4096); kf[5] = *(const __attribute__((address_space(3))) bf16x8*)(kp + 4608);
    kf[6] = *(const __attribute__((address_space(3))) bf16x8*)(kp + 6144); kf[7] = *(const __attribute__((address_space(3))) bf16x8*)(kp + 6656);
}
__device__ __forceinline__ void kload2(bf16x8* kf, lds_cptr kp, int j) { kf[2 * j] = *(const __attribute__((address_space(3))) bf16x8*)(kp + j * 2048); kf[2 * j + 1] = *(const __attribute__((address_space(3))) bf16x8*)(kp + j * 2048 + 512); }
__device__ __forceinline__ s16x4 vtr(lds_cptr p) { return __builtin_bit_cast(s16x4, __builtin_amdgcn_ds_read_tr16_b64_v4i16((__attribute__((address_space(3))) v4i16_t*)p)); }
__device__ __forceinline__ void pv(f32x16* o, int vb, bf16x8 pa0, bf16x8 pa1, bf16x8 pa2, bf16x8 pa3) {
#pragma unroll
    for (int d0 = 0; d0 < 2; ++d0) { s16x4 lo[4], hi[4];
#pragma unroll
        for (int ks = 0; ks < 4; ++ks) {
            asm volatile("ds_read_b64_tr_b16 %0,%1 offset:%c2" : "=&v"(lo[ks]) : "v"(vb), "i"(d0 * 4096 + ks * 1024) : "memory");
            asm volatile("ds_read_b64_tr_b16 %0,%1 offset:%c2" : "=&v"(hi[ks]) : "v"(vb), "i"(d0 * 4096 + ks * 1024 + 512) : "memory"); }
        asm volatile("s_waitcnt lgkmcnt(0)" ::: "memory"); SBAR();
#define PK(k) (bf16x8){lo[k][0], lo[k][1], lo[k][2], lo[k][3], hi[k][0], hi[k][1], hi[k][2], hi[k][3]}
        o[d0] = __builtin_amdgcn_mfma_f32_32x32x16_bf16(pa0, PK(0), o[d0], 0, 0, 0);
        o[d0] = __builtin_amdgcn_mfma_f32_32x32x16_bf16(pa1, PK(1), o[d0], 0, 0, 0);
        o[d0] = __builtin_amdgcn_mfma_f32_32x32x16_bf16(pa2, PK(2), o[d0], 0, 0, 0);
        o[d0] = __builtin_amdgcn_mfma_f32_32x32x16_bf16(pa3, PK(3), o[d0], 0, 0, 0);
#undef PK
    }
}
__device__ __forceinline__ void cinit(f32x16& c0, f32x16& c1, float cbh, float slope2) {
#pragma unroll
    for (int r = 0; r < 16; ++r) { const float kq = (float)((r & 3) + 8 * (r >> 2)); c0[r] = __builtin_fmaf(slope2, kq, cbh); c1[r] = __builtin_fmaf(slope2, kq + 32.0f, cbh); }
}

__device__ __forceinline__ void attn_unit(int b, int h, int qb, const bf16_t* Q, const bf16_t* __restrict__ K, const bf16_t* __restrict__ V, bf16_t* Y, const float* KM, float ref, int t_lo, char* shm, int tid_in) {
    int tid = tid_in; asm volatile("" : "+v"(tid));
    const int lane = tid & 63, r32 = lane & 31, hi = lane >> 5; const int wid = __builtin_amdgcn_readfirstlane(tid >> 6);
    const long rowbase = (long)b * SEQ; const int q0 = qb * QB;
    const bf16_t* Qw = Q + (rowbase + q0 + wid * QBLK) * QP + h * D;
    const bf16_t* Kh = K + (rowbase + (long)t_lo * KVBLK) * QP + h * D; const bf16_t* Vh = V + (rowbase + (long)t_lo * KVBLK) * QP + h * D;
    const unsigned lds0 = (unsigned)(uintptr_t)shm;
    const bf16_t* ksrc = Kh + (long)lane * QP + wid * 8;
    const bf16_t* vsrc = Vh + (long)(16 * (wid & 3) + (lane >> 2)) * QP + (wid >> 2) * 32 + (lane & 3) * 8;
    const unsigned kdst = lds0 + LDS_K + wid * 1024, vdst = lds0 + LDS_V + wid * 1024;
#define DMA_K(t, slot) glds16(ksrc + (long)(t) * KVBLK * QP, (unsigned)__builtin_amdgcn_readfirstlane(kdst + (slot)))
#define DMA_V(t, slot) glds16(vsrc + (long)(t) * KVBLK * QP, (unsigned)__builtin_amdgcn_readfirstlane(vdst + (slot)))
    const int vb0 = (int)(lds0 + LDS_V) + ((lane >> 4) & 1) * 32 + (lane & 3) * 8 + (4 * hi + ((lane & 15) >> 2)) * 64;
    bf16x8 kf[8];
    const lds_cptr shm3 = (lds_cptr)shm; const lds_cptr kp0 = shm3 + LDS_K + hi * 1024 + r32 * 16; const lds_cptr vp0 = shm3 + LDS_V + ((lane >> 4) & 1) * 32 + (lane & 3) * 8 + (4 * hi + ((lane & 15) >> 2)) * 64;
    const int NT = (q0 + QB) / KVBLK - t_lo;
    DMA_K(0, 0); DMA_V(0, 0); DMA_K(1, SLOTB);
    bf16x8 qr[4];
#pragma unroll
    for (int d0 = 0; d0 < 4; ++d0) qr[d0] = *reinterpret_cast<const bf16x8*>(&Qw[(long)r32 * QP + d0 * 16 + hi * 8]);
    unsigned selmask;
    {
        f32x16 gt = f32x16{};
        const float* kmr = KM + ((size_t)(b * NH + h) * 16 + (r32 & 15)) * 64 + 8 * hi;
#pragma unroll
        for (int d0 = 0; d0 < 4; ++d0) {
            f32x4 k0 = *(const f32x4*)(kmr + 16 * d0), k1 = *(const f32x4*)(kmr + 16 * d0 + 4);
            if (r32 >= 16) { k0 = (f32x4){0.f, 0.f, 0.f, 0.f}; k1 = k0; }
            u32x4 wh, wl; float lo8[8], x8[8] = {k0[0], k0[1], k0[2], k0[3], k1[0], k1[1], k1[2], k1[3]}; unsigned hb[8];
#pragma unroll
            for (int j = 0; j < 8; ++j) { hb[j] = f2bf(x8[j]); lo8[j] = x8[j] - bf2f(hb[j]); }
            wh.x = hb[0] | (hb[1] << 16); wh.y = hb[2] | (hb[3] << 16); wh.z = hb[4] | (hb[5] << 16); wh.w = hb[6] | (hb[7] << 16);
            wl.x = pk2(lo8[0], lo8[1]); wl.y = pk2(lo8[2], lo8[3]); wl.z = pk2(lo8[4], lo8[5]); wl.w = pk2(lo8[6], lo8[7]);
            gt = __builtin_amdgcn_mfma_f32_32x32x16_bf16(__builtin_bit_cast(bf16x8, wh), qr[d0], gt, 0, 0, 0);
            gt = __builtin_amdgcn_mfma_f32_32x32x16_bf16(__builtin_bit_cast(bf16x8, wl), qr[d0], gt, 0, 0, 0);
        }
        float g[16];
#pragma unroll
        for (int r = 0; r < 8; ++r) { const float mine = gt[r], oth = __shfl_xor(mine, 32); const int nb = (r & 3) + 8 * (r >> 2);
            g[nb] = hi ? oth : mine; g[nb + 4] = hi ? mine : oth; }
#pragma unroll
        for (int n = 0; n < 16; ++n) if (n >= qb) g[n] = -3.0e38f;
        unsigned m = 0;
#pragma unroll
        for (int s = 0; s < 3; ++s) { float best = g[0]; int bi = 0;
#pragma unroll
            for (int n = 1; n < 16; ++n) if (g[n] > best) { best = g[n]; bi = n; }
            m |= 1u << bi;
#pragma unroll
            for (int n = 0; n < 16; ++n) if (n == bi) g[n] = -INFINITY; }
        selmask = (qb <= 3) ? ((1u << qb) - 1u) : m;
    }
    const float slope2 = __builtin_amdgcn_exp2f(-(float)(h + 1)) * LOG2E;
    const int qrel = wid * QBLK + r32;
    const float tqf = (float)(q0 + qrel);
#define CBH(t) ((((t) >= NT - 4) || ((selmask >> (((t) + t_lo) >> 2)) & 1u)) ? __builtin_fmaf(slope2, (float)(64 * ((t) + t_lo) + 4 * hi) - tqf, -ref) : -1.0e30f)
    float l_reg = 0.f; f32x16 o[2]; o[0] = f32x16{}; o[1] = f32x16{};
#define CMASK(P0, P1, t) do { int jb_ = (t) - (NT - 4); if (jb_ >= 0) cmask(P0, P1, jb_, qrel, hi); } while (0)
    f32x16 pA0, pA1, pB0, pB1;
    int sl_prev = 0, sl_cur = 0, sl_next = SLOTB;
#define ROT() do { sl_prev = sl_cur; sl_cur = sl_next; sl_next = (sl_next == (NSLOT - 1) * SLOTB) ? 0 : sl_next + SLOTB; } while (0)
    DMA_K(2, 2 * SLOTB);
    cinit(pA0, pA1, CBH(0), slope2);
    WAIT_BAR(3);
    { const char* kb = shm + LDS_K + hi * 1024 + r32 * 16;
#pragma unroll
      for (int d0 = 0; d0 < 4; ++d0) { const bf16x8 b0 = *reinterpret_cast<const bf16x8*>(kb + d0 * 2048); const bf16x8 b1 = *reinterpret_cast<const bf16x8*>(kb + d0 * 2048 + 512);
          pA0 = __builtin_amdgcn_mfma_f32_32x32x16_bf16(b0, qr[d0], pA0, 0, 0, 0); pA1 = __builtin_amdgcn_mfma_f32_32x32x16_bf16(b1, qr[d0], pA1, 0, 0, 0); } }
    CMASK(pA0, pA1, 0);
#pragma unroll
    for (int r = 0; r < 16; ++r) { pA0[r] = __builtin_amdgcn_exp2f(pA0[r]); pA1[r] = __builtin_amdgcn_exp2f(pA1[r]); }
    cinit(pB0, pB1, CBH(1), slope2);
    WAIT_BAR(0);
    DMA_K(3, 0); DMA_V(1, SLOTB);
    ROT();
    kload8(kf, kp0 + sl_cur);
    WAIT_BAR(2);
    s16x4 vlo[8], vhi[8]; u32x4 pw0, pw1, pw2, pw3;
#define PKW(P, B) cvtpk_s(P[B], P[B + 1])
#define PAF(k) __builtin_bit_cast(bf16x8, pw##k)
#define VFR(i) (bf16x8){vlo[i][0], vlo[i][1], vlo[i][2], vlo[i][3], vhi[i][0], vhi[i][1], vhi[i][2], vhi[i][3]}
#define PIN(x) asm volatile("" : "+v"(x))
#define GAPA(MF, A0, A1, A2, A3, W0, W1, PW) do { MF; sacc += A0; sacc += A1; sacc += A2; sacc += A3; PIN(sacc); W0; W1; PIN(PW); SBAR(); } while (0)
#define EX(v) __builtin_amdgcn_exp2f(v)
#define GAPB(MF, X, B) do { MF; X[B] = EX(X[B]); X[B + 1] = EX(X[B + 1]); X[B + 2] = EX(X[B + 2]); X[B + 3] = EX(X[B + 3]); PIN(X); SBAR(); } while (0)
#define VRD(i) do { vlo[i] = vtr(vp_ + (((i) >> 2) * 4096 + ((i) & 3) * 1024)); vhi[i] = vtr(vp_ + (((i) >> 2) * 4096 + ((i) & 3) * 1024 + 512)); } while (0)
#define KRD(G, j) do { if (G) { kload2(kf, kp0 + sl_next, j); SBAR(); } } while (0)
#define STEP(C0, C1, P0, P1, t, GK, GV, GL) do { SBAR(); \
    const lds_cptr vp_ = vp0 + sl_prev; \
    VRD(0); SBAR(); float sacc = (P0[0] + P0[1]); \
    GAPA(C0 = __builtin_amdgcn_mfma_f32_32x32x16_bf16(kf[0], qr[0], C0, 0, 0, 0), P0[2], P0[3], P0[4], P0[5],     pw0[0] = PKW(P0, 0), pw0[1] = PKW(P0, 2), pw0); \
    VRD(4); SBAR(); GAPA(C1 = __builtin_amdgcn_mfma_f32_32x32x16_bf16(kf[1], qr[0], C1, 0, 0, 0), P0[6], P0[7], P0[8], P0[9],     pw0[2] = PKW(P0, 4), pw0[3] = PKW(P0, 6), pw0); \
    VRD(1); SBAR(); GAPA(C0 = __builtin_amdgcn_mfma_f32_32x32x16_bf16(kf[2], qr[1], C0, 0, 0, 0), P0[10], P0[11], P0[12], P0[13], pw1[0] = PKW(P0, 8), pw1[1] = PKW(P0, 10), pw1); \
    VRD(5); SBAR(); GAPA(C1 = __builtin_amdgcn_mfma_f32_32x32x16_bf16(kf[3], qr[1], C1, 0, 0, 0), P0[14], P0[15], P1[0], P1[1],   pw1[2] = PKW(P0, 12), pw1[3] = PKW(P0, 14), pw1); \
    VRD(2); SBAR(); GAPA(C0 = __builtin_amdgcn_mfma_f32_32x32x16_bf16(kf[4], qr[2], C0, 0, 0, 0), P1[2], P1[3], P1[4], P1[5],     pw2[0] = PKW(P1, 0), pw2[1] = PKW(P1, 2), pw2); \
    VRD(6); SBAR(); GAPA(C1 = __builtin_amdgcn_mfma_f32_32x32x16_bf16(kf[5], qr[2], C1, 0, 0, 0), P1[6], P1[7], P1[8], P1[9],     pw2[2] = PKW(P1, 4), pw2[3] = PKW(P1, 6), pw2); \
    VRD(3); SBAR(); GAPA(C0 = __builtin_amdgcn_mfma_f32_32x32x16_bf16(kf[6], qr[3], C0, 0, 0, 0), P1[10], P1[11], P1[12], P1[13], pw3[0] = PKW(P1, 8), pw3[1] = PKW(P1, 10), pw3); \
    VRD(7); SBAR(); GAPA(C1 = __builtin_amdgcn_mfma_f32_32x32x16_bf16(kf[7], qr[3], C1, 0, 0, 0), P1[14], P1[15], 0.f, 0.f,       pw3[2] = PKW(P1, 12), pw3[3] = PKW(P1, 14), pw3); \
    l_reg += sacc; \
    if (GK) { DMA_K((t) + 3, sl_cur); } if (GV) { DMA_V((t) + 1, sl_next); } \
    CMASK(C0, C1, t); \
    SBAR(); \
    GAPB(o[0] = __builtin_amdgcn_mfma_f32_32x32x16_bf16(PAF(0), VFR(0), o[0], 0, 0, 0), C0, 0); \
    GAPB(o[1] = __builtin_amdgcn_mfma_f32_32x32x16_bf16(PAF(0), VFR(4), o[1], 0, 0, 0), C0, 4); \
    KRD(GL, 0); GAPB(o[0] = __builtin_amdgcn_mfma_f32_32x32x16_bf16(PAF(1), VFR(1), o[0], 0, 0, 0), C0, 8); \
    KRD(GL, 1); GAPB(o[1] = __builtin_amdgcn_mfma_f32_32x32x16_bf16(PAF(1), VFR(5), o[1], 0, 0, 0), C0, 12); \
    KRD(GL, 2); GAPB(o[0] = __builtin_amdgcn_mfma_f32_32x32x16_bf16(PAF(2), VFR(2), o[0], 0, 0, 0), C1, 0); \
    KRD(GL, 3); GAPB(o[1] = __builtin_amdgcn_mfma_f32_32x32x16_bf16(PAF(2), VFR(6), o[1], 0, 0, 0), C1, 4); \
    GAPB(o[0] = __builtin_amdgcn_mfma_f32_32x32x16_bf16(PAF(3), VFR(3), o[0], 0, 0, 0), C1, 8); \
    GAPB(o[1] = __builtin_amdgcn_mfma_f32_32x32x16_bf16(PAF(3), VFR(7), o[1], 0, 0, 0), C1, 12); \
    cinit(P0, P1, CBH((t) + 1), slope2); PIN(P0); PIN(P1); SBAR();   \
    } while (0)
    int t = 1;
#undef CMASK
#define CMASK(P0, P1, t) do {} while (0)
    for (; t + 5 < NT; t += 2) {
        STEP(pB0, pB1, pA0, pA1, t, true, true, true);     WAIT_BAR(2); ROT();
        STEP(pA0, pA1, pB0, pB1, t + 1, true, true, true); WAIT_BAR(2); ROT();
    }
#undef CMASK
#define CMASK(P0, P1, t) do { int jb_ = (t) - (NT - 4); if (jb_ >= 0) cmask(P0, P1, jb_, qrel, hi); } while (0)
#define ENDW(tt) do { if ((tt) + 3 < NT) { WAIT_BAR(2); } else if ((tt) + 2 < NT) { WAIT_BAR(1); } else { WAIT_BAR(0); } } while (0)
    for (; t + 1 < NT; t += 2) {
        STEP(pB0, pB1, pA0, pA1, t, (t + 3 < NT), (t + 1 < NT), (t + 1 < NT));         ENDW(t);     ROT();
        STEP(pA0, pA1, pB0, pB1, t + 1, (t + 4 < NT), (t + 2 < NT), (t + 2 < NT));     ENDW(t + 1); ROT();
    }
    STEP(pB0, pB1, pA0, pA1, NT - 1, false, false, false);
    { float sacc = pB0[0] + pB0[1];
#pragma unroll
      for (int r = 2; r < 16; ++r) sacc += pB0[r];
#pragma unroll
      for (int r = 0; r < 16; ++r) sacc += pB1[r];
      l_reg += sacc;
      pw0 = (u32x4){PKW(pB0, 0), PKW(pB0, 2), PKW(pB0, 4), PKW(pB0, 6)}; pw1 = (u32x4){PKW(pB0, 8), PKW(pB0, 10), PKW(pB0, 12), PKW(pB0, 14)};
      pw2 = (u32x4){PKW(pB1, 0), PKW(pB1, 2), PKW(pB1, 4), PKW(pB1, 6)}; pw3 = (u32x4){PKW(pB1, 8), PKW(pB1, 10), PKW(pB1, 12), PKW(pB1, 14)};
      SBAR(); pv(o, vb0 + sl_cur, PAF(0), PAF(1), PAF(2), PAF(3)); }
#undef PKW
#undef PAF
#undef VFR
#undef PIN
#undef GAPA
#undef GAPB
#undef EX
#undef VRD
#undef KRD
#undef STEP
#undef ENDW
    { l_reg += __shfl_xor(l_reg, 32); }
    float* wsf = (float*)(shm + LDS_WS) + wid * 64;
    if (hi == 0) wsf[32 + r32] = l_reg; asm volatile("s_waitcnt lgkmcnt(0)" ::: "memory");
    float rli[16];
#pragma unroll
    for (int r = 0; r < 16; ++r) rli[r] = __builtin_amdgcn_rcpf(wsf[32 + crow(r, hi)]);
    bf16_t* Ow = Y + (rowbase + q0 + wid * QBLK) * DM + 512 + h * D;
    { bf16_t* stg = (bf16_t*)(shm + LDS_OST) + wid * 2048;
#pragma unroll
      for (int r = 0; r < 16; ++r) { const int orow = crow(r, hi);
#pragma unroll
          for (int d0 = 0; d0 < 2; ++d0) stg[orow * 64 + d0 * 32 + r32] = (bf16_t)f2bf(o[d0][r] * rli[r]); }
      asm volatile("s_waitcnt lgkmcnt(0)" ::: "memory");
#pragma unroll
      for (int i = 0; i < 4; ++i) { const int row = i * 8 + (lane >> 3), ch = lane & 7; const u32x4 v = *(const u32x4*)(stg + row * 64 + ch * 8); *(u32x4*)(Ow + (long)row * DM + ch * 8) = v; } }
    asm volatile("s_waitcnt lgkmcnt(0)\n\ts_barrier" ::: "memory");
#undef DMA_K
#undef DMA_V
#undef CMASK
#undef CBH
#undef ROT
}
#undef SBAR
#undef WAIT_BAR
}

__device__ constexpr int PROBE_REP[9] = {1, 1, 1, 1, 1, 1, 1, 1, 1};
#define WSP(T, off) ((T*)(a.ws + (off)))
#define P_WT_in WSP(bf16_t, WS_WIN)
#define P_WT_out WSP(bf16_t, WS_WOUT)
#define P_WT_up WSP(bf16_t, WS_WUP)
#define P_WT_dn WSP(bf16_t, WS_WDN)
#define P_WT_g WSP(bf16_t, WS_WG)
#define P_WT_p WSP(bf16_t, WS_WP)
#define P_GW WSP(bf16_t, WS_GW)
#define P_XN WSP(bf16_t, WS_XN)
#define P_PB WSP(bf16_t, WS_PB)
#define P_PRJ WSP(bf16_t, WS_PRJ)
#define CLS_ ((size_t)(blockIdx.x & 7u))
#define P_XL ((bf16_t*)(a.ws + WS_R + CLS_ * SLAB) - CLS_ * SEQ * 512)
#define P_GL (P_XL + (size_t)SEQ * 512)
#define P_Q (P_XL + (size_t)SEQ * 1024)
#define P_K (P_XL + (size_t)SEQ * 1536)
#define P_V (P_XL + (size_t)SEQ * 2048)
#define P_Y ((bf16_t*)(a.ws + WS_R + CLS_ * SLAB + 20 * MiB) - CLS_ * SEQ * DM)
#define P_RINV0 WSP(float, WS_RINV0)
#define P_XB1 ((bf16_t*)(a.ws + WS_R + CLS_ * SLAB) - CLS_ * SEQ * DM)
#define P_XB2 P_XN
#define P_ACT ((bf16_t*)(a.ws + WS_R + CLS_ * SLAB + 8 * MiB) - CLS_ * SEQ * DFF)
#define P_KM WSP(float, WS_KM)
#define P_SS1 WSP(float, WS_SS1)
#define P_SS2 WSP(float, WS_SS2)
#define P_GT WSP(float, WS_GT)
#define P_PART WSP(float, WS_PART)
#define P_VH WSP(float, WS_VH)
__global__ void __launch_bounds__(512, 2) mega(Args a) {
    extern __shared__ __attribute__((aligned(16))) unsigned char lds_raw[];
    LAS unsigned char* const ldsb = (LAS unsigned char*)lds_raw;
    const int wave_s = __builtin_amdgcn_readfirstlane((int)threadIdx.x >> 6);
    volatile LAS unsigned* MISC = (volatile LAS unsigned*)(ldsb + MISC_OFF);
    for (int u = threadIdx.x; u < (LDS_BYTES - RING_BYTES) / 4; u += NWAVES * 64) ((LAS unsigned*)(ldsb + RING_BYTES))[u] = 0u;
    __syncthreads();
    XcdBarrier bar = xcd_barrier_post((unsigned*)(a.ws + WS_CTL), MISC + 8);
    if (gridDim.x != 256u) __builtin_trap();
    const int lo = a.ph_lo, hi_ = a.ph_hi;
#define IN(k) (lo <= (k) && (k) < hi_)
#define REPEAT(k) for (int rep_ = 0; rep_ < PROBE_REP[k]; ++rep_)
#define SEAM(k) do { if (IN(k) && IN((k) + 1)) xcd_barrier(bar); } while (0)
#define PHASE_IDS() int lane_; asm volatile("v_mbcnt_lo_u32_b32 %0, -1, 0\n\tv_mbcnt_hi_u32_b32 %0, -1, %0" : "=&v"(lane_)); const int tid = wave_s * 64 + lane_; const int lane = tid & 63, wave = wave_s; \
    const int G = gridDim.x, vcu = (G % 8 == 0) ? ((int)blockIdx.x % 8) * (G / 8) + (int)blockIdx.x / 8 : (int)blockIdx.x; const int gw = vcu * NWAVES + wave, NGW = G * NWAVES; (void)lane; (void)gw; (void)NGW;

    REPEAT(0) { if (rep_) xcd_barrier(bar);
    if (IN(0)) {
        PHASE_IDS();
        LAS float* scr = (LAS float*)(ldsb + wave * 16384);
        constexpr int I_IN = (DM / 64) * (INW / 32), I_OUT = (DM / 64) * (DM / 32), I_UP = (DM / 64) * (2 * DFF / 32), I_DN = (DFF / 64) * (DM / 32), I_G = I_OUT, I_P = (PLE / 64) * (DM / 32), I_GW = 16 * 2;
        constexpr int NITEMS = I_IN + I_OUT + I_UP + I_DN + I_G + I_P + I_GW;
        for (int it = gw; it < NITEMS; it += NGW) {
            int r = it;
            if (r < I_IN) { p0_transpose_item(a.in[3], INW, INW, P_WT_in, DM, nullptr, scr, r, lane); continue; } r -= I_IN;
            if (r < I_OUT) { p0_transpose_item(a.in[13], DM, DM, P_WT_out, DM, nullptr, scr, r, lane); continue; } r -= I_OUT;
            if (r < I_UP) { p0_transpose_item(a.in[15], 2 * DFF, 2 * DFF, P_WT_up, DM, a.in[14], scr, r, lane); continue; } r -= I_UP;
            if (r < I_DN) { p0_transpose_item(a.in[18], DM, DM, P_WT_dn, DFF, nullptr, scr, r, lane); continue; } r -= I_DN;
            if (r < I_G) { p0_transpose_item(a.in[20], DM, DM, P_WT_g, DM, a.in[19], scr, r, lane); continue; } r -= I_G;
            if (r < I_P) { p0_transpose_item(a.in[21], DM, DM, P_WT_p, PLE, nullptr, scr, r, lane); continue; } r -= I_P;
            { const int mat = r >> 1, sub = r & 1, gsel = mat >> 3, blk = mat & 7;
              p0_transpose_item((gsel ? a.in[8] : a.in[6]) + (size_t)blk * 4096, 64, 64, P_GW + (size_t)gsel * 32768 + (size_t)blk * 4096, 64, nullptr, scr, sub, lane); }
        }
        VM_WAIT(); __syncthreads();
        if (tid == 0) (void)xb_add((unsigned*)(a.ws + WS_CTL) + GB_WCNT, 1u);
        const int cls = vcu >> 5, cw = (vcu & 31) * NWAVES + wave;
        { const int i = cw * 64 + lane; if (i < NH * 16 * 64) P_KM[cls * (NH * 16 * 64) + i] = 0.f; }
        { const float* xin = a.in[0]; const f32x4* gr = (const f32x4*)a.in[2] + lane; bf16_t* xn = P_XN; float* rinv = P_RINV0;
          f32x4 gg[4];
#pragma unroll
          for (int j = 0; j < 4; ++j) gg[j] = gr[64 * j];
          constexpr int CNW = 32 * NWAVES; const int mend = (cls + 1) * SEQ;
          for (int m0 = cls * SEQ + cw; m0 < mend; m0 += 4 * CNW) {
              f32x4 v[4][4];
#pragma unroll
              for (int r = 0; r < 4; ++r) { const int m = m0 + r * CNW; const f32x4* xr = (const f32x4*)(xin + (size_t)(m < mend ? m : m0) * DM) + lane;
#pragma unroll
                  for (int j = 0; j < 4; ++j) v[r][j] = __builtin_nontemporal_load(xr + 64 * j); }
#pragma unroll
              for (int r = 0; r < 4; ++r) { const int m = m0 + r * CNW; float s = 0.f;
#pragma unroll
                  for (int j = 0; j < 4; ++j) s += (v[r][j][0] * v[r][j][0] + v[r][j][1] * v[r][j][1]) + (v[r][j][2] * v[r][j][2] + v[r][j][3] * v[r][j][3]);
                  const float ms = wave_sum(s) * (1.0f / DM) + EPS; const float rstd = rsqrtf(ms);
                  if (m < mend) { if (lane == 0) rinv[m] = ms * rstd;
                      unsigned long long* o8 = (unsigned long long*)(xn + (size_t)m * DM) + lane;
#pragma unroll
                      for (int j = 0; j < 4; ++j) o8[64 * j] = (unsigned long long)pk2(v[r][j][0] * rstd * gg[j][0], v[r][j][1] * rstd * gg[j][1]) | ((unsigned long long)pk2(v[r][j][2] * rstd * gg[j][2], v[r][j][3] * rstd * gg[j][3]) << 32); } } } }
        { const f32x4* pin = (const f32x4*)a.in[1]; unsigned long long* pb = (unsigned long long*)P_PB; const size_t n4 = (size_t)(cls + 1) * SEQ * PLE / 4, st = (size_t)32 * NWAVES * 64;
          for (size_t i0 = (size_t)cls * SEQ * PLE / 4 + (size_t)cw * 64 + lane; i0 < n4; i0 += 8 * st) { f32x4 v[8];
#pragma unroll
              for (int q = 0; q < 8; ++q) { const size_t i = i0 + q * st; v[q] = __builtin_nontemporal_load(pin + (i < n4 ? i : i0)); }
#pragma unroll
              for (int q = 0; q < 8; ++q) { const size_t i = i0 + q * st; if (i < n4) pb[i] = (unsigned long long)pk2(v[q][0], v[q][1]) | ((unsigned long long)pk2(v[q][2], v[q][3]) << 32); } } }
    }
    }
    if (IN(0) && IN(1)) {
        if (threadIdx.x == 0) { unsigned* bar_ = (unsigned*)(a.ws + WS_CTL); XB_SPIN(xb_ld(&bar_[GB_WCNT]) < gridDim.x, bar_); }
        grp_barrier((unsigned*)(a.ws + WS_CTL), MISC + 10); }
    REPEAT(1) { if (rep_) xcd_barrier(bar);
    if (IN(1)) {
        { PHASE_IDS(); pg8::Gemm g{P_XN, P_WT_in, 0, MTOK, INW, DM, 0}; pg8::StaticOrder S; S.init(MTOK, INW, G, (int)blockIdx.x); EpiInProj E{P_XL, a.in[11], a.in[12], P_KM};
          pg8::gemm_phase<EpiInProj, true>(ldsb, g, S, E, tid); }
        { PHASE_IDS(); pg8::Gemm g{P_PB, P_WT_p, 0, MTOK, DM, PLE, 0}; pg8::StaticOrder S; S.init(MTOK, DM, G, (int)blockIdx.x); EpiBf16Plain E{P_PRJ, 0};
          pg8::gemm_phase<EpiBf16Plain, true>(ldsb, g, S, E, tid); }
    }
    }
    do { if (IN(1) && IN(3)) grp_barrier((unsigned*)(a.ws + WS_CTL), MISC + 10); } while (0);
    REPEAT(3) { if (rep_) xcd_barrier(bar);
    if (IN(3)) {
        { PHASE_IDS(); unsigned* cntL = (unsigned*)(a.ws + WS_CTL) + 4096;
          const LruP LP{P_XL, P_GL, a.in[4], a.in[5], P_GW, P_GW + 32768, a.in[7], a.in[9], a.in[10], WSP(f32x2, WS_SUMM), P_Y, (unsigned*)a.out};
          {
            const int l_ = vcu & 31, u0 = ((vcu >> 5) << 7) | ((l_ >> 2) << 4) | (l_ & 3);
            lru_setup(LP, ldsb, l_ >> 2, tid);
            LruTile T; lru_tile_load(LP, T, u0, wave, lane);
#pragma nounroll
            for (int u = u0; u < u0 + 16; u += 4) lru_unit_fused(LP, ldsb, cntL, T, u, (u + 4 < u0 + 16) ? u + 4 : -1, wave, lane); } }
        { PHASE_IDS();
          float mq = fabsf(a.in[11][lane]), mk = fabsf(a.in[12][lane]); mq = wave_max(mq); mk = wave_max(mk);
          const float ref = C2 * 64.0f * mq * mk;
          LAS int* QL = (LAS int*)(ldsb + attn::LDS_BYTES_A);
#define ATT_TLO(h_, qb_) ({ const float ds_ = (2.0f * ref + 40.0f) / (exp2f(-(float)((h_) + 1)) * LOG2E); const float sm_ = (float)((qb_) * 256) - ds_; int tl_ = sm_ > 0.f ? (int)(sm_ * (1.0f / 64.0f)) : 0; tl_ &= ~1; tl_ = tl_ > 4 * (qb_) ? 4 * (qb_) : tl_; tl_; })
          if (tid < 128) QL[tid] = 4 * ((tid & 15) + 1) - ATT_TLO(tid >> 4, tid & 15);
          __syncthreads();
          if (tid < 128) { const int my = QL[tid]; int rank = 0; for (int j = 0; j < 128; ++j) { const int cj = QL[j]; rank += (cj > my || (cj == my && j < tid)) ? 1 : 0; } QL[128 + rank] = tid; }
          __syncthreads();
          unsigned* qctr = (unsigned*)(a.ws + WS_CTL) + 8192 + 64 * ((int)blockIdx.x & 7);
          for (;;) {
              if (tid == 0) QL[256] = (int)__hip_atomic_fetch_add(qctr, 1u, __ATOMIC_RELAXED, __HIP_MEMORY_SCOPE_AGENT);
              __syncthreads();
              const int k = QL[256];
              __syncthreads();
              if (k >= NH * 16) break;
              const int combo = __builtin_amdgcn_readfirstlane(QL[128 + k]), b = (int)blockIdx.x & 7, h = combo >> 4, qb = combo & 15;
              const int tlo = __builtin_amdgcn_readfirstlane(ATT_TLO(h, qb));
              attn::attn_unit(b, h, qb, P_Q, P_K, P_V, P_Y, P_KM, ref, tlo, (char*)lds_raw, tid); }
#undef ATT_TLO
        }
    }
    }
    do { if (IN(3) && IN(4)) grp_barrier((unsigned*)(a.ws + WS_CTL), MISC + 10); } while (0);
    REPEAT(4) { if (rep_) xcd_barrier(bar);
    if (IN(4)) { PHASE_IDS(); pg8::Gemm g{P_Y, P_WT_out, 0, MTOK, DM, DM, 0}; pg8::StaticOrder S; S.init(MTOK, DM, G, (int)blockIdx.x); EpiResid<2> E{P_XN, P_XB1, P_SS1, P_RINV0, a.in[2]};
        pg8::gemm_phase<EpiResid<2>, true>(ldsb, g, S, E, tid); }
    }
    do { if (IN(4) && IN(5)) grp_barrier((unsigned*)(a.ws + WS_CTL), MISC + 10); } while (0);
    REPEAT(5) { if (rep_) xcd_barrier(bar);
    if (IN(5)) { PHASE_IDS(); pg8::Gemm g{P_XB1, P_WT_up, (size_t)DFF * DM * 2, MTOK, 2 * DFF, DM, 0}; pg8::StaticOrder S; S.init(MTOK, 2 * DFF, G, (int)blockIdx.x);
        pg8::Unit u0, u1; const int nun = (S.nwg - (int)blockIdx.x + G - 1) / G; S.next(0, u0); S.next(nun - 1, u1);
        { const int row = (tid < 256 ? u0.pm : u1.pm) * 256 + (tid & 255); const f32x4* sp = (const f32x4*)(P_SS1 + (size_t)row * 16); const f32x4 p0 = sp[0], p1 = sp[1], p2 = sp[2], p3 = sp[3];
          const float s = ((p0[0] + p0[1]) + (p0[2] + p0[3])) + ((p1[0] + p1[1]) + (p1[2] + p1[3])) + (((p2[0] + p2[1]) + (p2[2] + p2[3])) + ((p3[0] + p3[1]) + (p3[2] + p3[3])));
          ((LAS float*)(ldsb + SPARE_RS))[tid] = rsqrtf(s * (1.0f / DM) + EPS); }
        __syncthreads();
        bool two = true; { pg8::Unit uq; for (int i_ = 0; S.next(i_, uq); ++i_) two = two && (uq.pm == u0.pm || uq.pm == u1.pm); }
        EpiUpFused E{P_ACT, a.in[16], a.in[17], P_GT, P_PART, P_VH, P_SS1, u0.pm, two ? u1.pm : -1};
        pg8::gemm_phase<EpiUpFused, true>(ldsb, g, S, E, tid); }
    }
    do { if (IN(5) && IN(7)) grp_barrier((unsigned*)(a.ws + WS_CTL), MISC + 10); } while (0);
    if (IN(7)) { PHASE_IDS(); pg8::Gemm g{P_ACT, P_WT_dn, 0, MTOK, DM, DFF, 0}; pg8::StaticOrder S; S.init(MTOK, DM, G, (int)blockIdx.x);
        { const float* GT = P_GT; const float* PART = P_PART; const float* VH = P_VH; const float* fcw = a.in[16]; bf16_t* ACT = P_ACT;
          pg8::Unit uu; for (int ui_ = 0; S.next(ui_, uu); ++ui_) {
#pragma unroll
              for (int it_ = 0; it_ < 4 * (DFF / 4) / (NWAVES * 64); ++it_) { const int i = tid + it_ * NWAVES * 64; const int c4 = i % (DFF / 4), sr4 = i / (DFF / 4), rr = sr4 & 1, strip = uu.pm * 2 + (sr4 >> 1), sr = strip * 2 + rr, j = c4 * 4, r0 = strip * 128;
                  f32x4 pre = __builtin_nontemporal_load((const f32x4*)(PART + (size_t)sr * DFF + j)); const f32x4 v = __builtin_nontemporal_load((const f32x4*)(VH + (size_t)sr * DFF + j));
                  if ((r0 & (SEQ - 1)) != 0) { const f32x4 p2 = *(const f32x4*)(GT + ((size_t)(strip - 1) * 2 + 0) * DFF + j), p1 = *(const f32x4*)(GT + ((size_t)(strip - 1) * 2 + 1) * DFF + j);
                      const f32x4 w0 = *(const f32x4*)(fcw + j), w1 = *(const f32x4*)(fcw + DFF + j);
                      if (rr == 0) pre = pre + w0 * p2 + w1 * p1; else pre = pre + w0 * p1; }
                  u32x2 w; w.x = pk2(gelu_tanh(pre[0]) * v[0], gelu_tanh(pre[1]) * v[1]); w.y = pk2(gelu_tanh(pre[2]) * v[2], gelu_tanh(pre[3]) * v[3]);
                  *(u32x2*)(ACT + (size_t)(r0 + rr) * DFF + j) = w; } }
          VM_WAIT(); __syncthreads(); }
        EpiResid<1> E{P_XB1, P_XB2, P_SS2, nullptr, nullptr};
        pg8::gemm_phase<EpiResid<1>, true>(ldsb, g, S, E, tid); }
    do { if (IN(7) && IN(8)) grp_barrier((unsigned*)(a.ws + WS_CTL), MISC + 10); } while (0);
    if (IN(8)) { PHASE_IDS(); pg8::Gemm g{P_XB2, P_WT_g, 0, MTOK, DM, DM, 0}; pg8::StaticOrder S; S.init(MTOK, DM, G, (int)blockIdx.x); EpiFinal E{a.out, P_XB2, P_PRJ, P_SS2};
        pg8::gemm_phase<EpiFinal, true>(ldsb, g, S, E, tid); }
#undef IN
#undef SEAM
}

#ifndef MK_N_LAUNCHES
#define MK_N_LAUNCHES 1
#endif
constexpr int N_PHASES = 9;
extern "C" void kernel_launch(void* const* d_in, const int* in_sizes, int n_in, void* d_out, int out_size, void* d_ws, size_t ws_size, hipStream_t stream) {
    static int grid = 0;
    if (grid == 0) {
        if (n_in != 22 || ws_size < WS_END || out_size != MTOK * DM) { fprintf(stderr, "kernel_launch: unexpected n_in %d, out_size %d or ws_size %zu\n", n_in, out_size, ws_size); grid = -1; return; }
        int dev = 0, cus = 0, per_cu = 0;
        if (hipGetDevice(&dev) != hipSuccess || hipDeviceGetAttribute(&cus, hipDeviceAttributeMultiprocessorCount, dev) != hipSuccess) { grid = -1; return; }
        if (hipFuncSetAttribute((const void*)mega, hipFuncAttributeMaxDynamicSharedMemorySize, LDS_BYTES) != hipSuccess) { fprintf(stderr, "kernel_launch: hipFuncSetAttribute failed\n"); grid = -1; return; }
        if (hipOccupancyMaxActiveBlocksPerMultiprocessor(&per_cu, (const void*)mega, NWAVES * 64, LDS_BYTES) != hipSuccess || per_cu < 1) fprintf(stderr, "kernel_launch: occupancy query says %d\n", per_cu);
        (void)hipGetLastError();
        grid = cus >= 128 ? (cus / 128) * 128 : cus;
    }
    if (grid < 0) return;
    (void)hipMemsetAsync((char*)d_ws + WS_CTL, 0, CTL_ZERO_BYTES, stream);
    Args a{};
    for (int i = 0; i < 22; ++i) a.in[i] = (const float*)d_in[i];
    a.out = (float*)d_out; a.ws = (unsigned char*)d_ws;
    if (MK_N_LAUNCHES == 1) { a.ph_lo = 0; a.ph_hi = N_PHASES; hipLaunchKernelGGL(mega, dim3(grid), dim3(NWAVES * 64), LDS_BYTES, stream, a); }
    else { for (int ph = 0; ph < N_PHASES; ++ph) { a.ph_lo = ph; a.ph_hi = ph + 1; hipLaunchKernelGGL(mega, dim3(grid), dim3(NWAVES * 64), LDS_BYTES, stream, a); } }
}
```
